# Optimizing an MI355X kernel written in HIP

```python
import math, functools
import jax, jax.numpy as jnp
from jax import lax
import numpy as np

D_MODEL = 1024
BATCH = 2
SEQ = 8192
DEPTH = 4
DEC_BATCH = 128
DEC_SEQ = 4
PAST_LEN = 8192
PAGE_SIZE = 128

MIX_WIDTH = D_MODEL
GLA_WIDTH = D_MODEL // 2
GLA_HEADS = 4
GLA_DV = GLA_WIDTH // GLA_HEADS
GLA_DK = GLA_DV // 2
GLA_QK = GLA_HEADS * GLA_DK
GATE_RANK = 16
GATE_NORMALIZER = 16.0
GLA_CHUNK = 64
SWA_HEAD_DIM = 64
SWA_HEADS = (MIX_WIDTH - GLA_WIDTH) // SWA_HEAD_DIM
SWA_KV_HEADS = SWA_HEADS // 4
SWA_GROUP = SWA_HEADS // SWA_KV_HEADS
WINDOW = 128
ROPE_THETA = 10000.0
D_FF = ((8 * D_MODEL // 3 + 255) // 256) * 256
NORM_EPS = 1e-6

_IN_SIZES = (GLA_QK, GLA_QK, GLA_WIDTH, GATE_RANK, GLA_WIDTH,
             SWA_HEADS * SWA_HEAD_DIM, SWA_KV_HEADS * SWA_HEAD_DIM, SWA_KV_HEADS * SWA_HEAD_DIM)
IN_COLS = sum(_IN_SIZES)
_SPLITS = tuple(int(s) for s in np.cumsum(_IN_SIZES)[:-1])

kernel_name = "hymba_gla_swa_sink_decoder_step"


def _rmsnorm(x, g):
    xf = x.astype(jnp.float32)
    y = xf * lax.rsqrt(jnp.mean(xf * xf, axis=-1, keepdims=True) + NORM_EPS)
    return (y * g.astype(jnp.float32)).astype(x.dtype)


def _rope(x, pos):
    half = x.shape[-1] // 2
    inv = ROPE_THETA ** (-jnp.arange(half, dtype=jnp.float32) / half)
    ang = pos.astype(jnp.float32)[:, None] * inv[None, :]
    cos = jnp.cos(ang)[None, :, None, :]
    sin = jnp.sin(ang)[None, :, None, :]
    xf = x.astype(jnp.float32)
    x1, x2 = xf[..., :half], xf[..., half:]
    return jnp.concatenate([x1 * cos - x2 * sin, x2 * cos + x1 * sin], axis=-1).astype(x.dtype)


def _gla(q, k, v, g, S0):
    B, T, H, K = q.shape
    V = v.shape[-1]
    C = math.gcd(T, GLA_CHUNK)
    n = T // C
    causal = jnp.tril(jnp.ones((C, C), dtype=bool))[None, :, :, None, None]

    def to_chunks(a):
        return a.reshape(B, n, C, H, a.shape[-1]).swapaxes(0, 1)

    def step(S, inp):
        qc, kc, vc, gc = inp
        b = jnp.cumsum(gc, axis=1)
        o_inter = jnp.einsum('bthk,bhkv->bthv', qc * jnp.exp(b), S)
        diff = b[:, :, None] - b[:, None, :]
        decay = jnp.where(causal, jnp.exp(jnp.where(causal, diff, 0.0)), 0.0)
        A = jnp.einsum('bthk,btshk,bshk->bhts', qc, decay, kc)
        o_intra = jnp.einsum('bhts,bshv->bthv', A, vc)
        b_last = b[:, -1]
        k_dec = kc * jnp.exp(b_last[:, None] - b)
        S_new = jnp.exp(b_last)[..., None] * S + jnp.einsum('bshk,bshv->bhkv', k_dec, vc)
        return S_new, o_inter + o_intra

    S, o = lax.scan(step, S0, (to_chunks(q), to_chunks(k), to_chunks(v), to_chunks(g)))
    return o.swapaxes(0, 1).reshape(B, T, H, V), S


def _sink_attention(q, k, v, sinks, qpos, kpos):
    hd = q.shape[-1]
    s = jnp.einsum('bnqkgd,bnskd->bnkgqs', q.astype(jnp.float32), k.astype(jnp.float32)) * (hd ** -0.5)
    diff = qpos[:, :, None] - kpos[:, None, :]
    mask = (diff >= 0) & (diff < WINDOW) & (kpos[:, None, :] >= 0)
    s = jnp.where(mask[None, :, None, None], s, -jnp.inf)
    sink = sinks.astype(jnp.float32).reshape(1, 1, SWA_KV_HEADS, SWA_GROUP, 1, 1)
    m = jnp.maximum(jnp.max(s, axis=-1, keepdims=True), sink)
    p = jnp.exp(s - m)
    denom = jnp.sum(p, axis=-1, keepdims=True) + jnp.exp(sink - m)
    return jnp.einsum('bnkgqs,bnskd->bnqkgd', p / denom, v.astype(jnp.float32))


def _swa_prompt(q, k, v, sinks):
    B, T = q.shape[0], q.shape[1]
    N = T // WINDOW
    qb = q.reshape(B, N, WINDOW, SWA_KV_HEADS, SWA_GROUP, SWA_HEAD_DIM)
    kb = k.reshape(B, N, WINDOW, SWA_KV_HEADS, SWA_HEAD_DIM)
    vb = v.reshape(B, N, WINDOW, SWA_KV_HEADS, SWA_HEAD_DIM)
    kk = jnp.concatenate([jnp.concatenate([jnp.zeros_like(kb[:, :1]), kb[:, :-1]], axis=1), kb], axis=2)
    vv = jnp.concatenate([jnp.concatenate([jnp.zeros_like(vb[:, :1]), vb[:, :-1]], axis=1), vb], axis=2)
    qpos = jnp.arange(T).reshape(N, WINDOW)
    kpos = (jnp.arange(N)[:, None] - 1) * WINDOW + jnp.arange(2 * WINDOW)[None, :]
    o = _sink_attention(qb, kk, vv, sinks, qpos, kpos)
    w_buf = min(WINDOW, PAST_LEN)
    return o.reshape(B, T, SWA_HEADS * SWA_HEAD_DIM), k[:, -w_buf:], v[:, -w_buf:]


def _swa_sample(q, k, v, sinks, kbuf, vbuf):
    B, T = q.shape[0], q.shape[1]
    W = kbuf.shape[1]
    keys = jnp.concatenate([kbuf.astype(k.dtype), k], axis=1)
    vals = jnp.concatenate([vbuf.astype(v.dtype), v], axis=1)
    qpos = (PAST_LEN + jnp.arange(T))[None]
    kpos = (PAST_LEN - W + jnp.arange(W + T))[None]
    o = _sink_attention(q.reshape(B, 1, T, SWA_KV_HEADS, SWA_GROUP, SWA_HEAD_DIM),
                        keys[:, None], vals[:, None], sinks, qpos, kpos)
    return o.reshape(B, T, SWA_HEADS * SWA_HEAD_DIM), keys[:, -W:], vals[:, -W:]


def _layer(x, pos, S0, attend, norm_attn, w_in, w_gk2, b_gk2, gla_norm, sinks, w_o,
           norm_ffn, w_gate, w_up, w_down):
    B, T, _ = x.shape
    f32 = jnp.float32
    h = _rmsnorm(x, norm_attn)
    z = h @ w_in
    gq, gk, gv, ga, gg, sq, sk, sv = jnp.split(z, _SPLITS, axis=-1)
    q = gq.reshape(B, T, GLA_HEADS, GLA_DK).astype(f32) * (GLA_DK ** -0.5)
    k = gk.reshape(B, T, GLA_HEADS, GLA_DK).astype(f32)
    v = gv.reshape(B, T, GLA_HEADS, GLA_DV).astype(f32)
    g = jax.nn.log_sigmoid((ga @ w_gk2 + b_gk2).astype(f32)) / GATE_NORMALIZER
    o, S = _gla(q, k, v, g.reshape(B, T, GLA_HEADS, GLA_DK), S0.astype(f32))
    o = _rmsnorm(o, gla_norm) * jax.nn.silu(gg.reshape(B, T, GLA_HEADS, GLA_DV).astype(f32))
    o_gla = o.reshape(B, T, GLA_WIDTH).astype(x.dtype)
    qs = _rope(sq.reshape(B, T, SWA_HEADS, SWA_HEAD_DIM), pos)
    ks = _rope(sk.reshape(B, T, SWA_KV_HEADS, SWA_HEAD_DIM), pos)
    vs = sv.reshape(B, T, SWA_KV_HEADS, SWA_HEAD_DIM)
    o_swa, kc, vc = attend(qs, ks, vs, sinks)
    x = x + jnp.concatenate([o_gla, o_swa.astype(x.dtype)], axis=-1) @ w_o
    h = _rmsnorm(x, norm_ffn)
    x = x + (jax.nn.silu(h @ w_gate) * (h @ w_up)) @ w_down
    return x, S, kc, vc


def setup_inputs(seed: int = 0) -> dict:
    key = jax.random.key(seed)
    ks = jax.random.split(key, 20)
    nrm = jax.random.normal
    w_buf = min(WINDOW, PAST_LEN)
    return {
        "x_prompt": nrm(ks[0], (BATCH, SEQ, D_MODEL), jnp.float32),
        "x_sample": nrm(ks[1], (DEC_BATCH, DEC_SEQ, D_MODEL), jnp.float32),
        "state_gla": 0.5 * nrm(ks[2], (DEPTH, DEC_BATCH, GLA_HEADS, GLA_DK, GLA_DV), jnp.float32),
        "cache_swa_k": nrm(ks[3], (DEPTH, DEC_BATCH, w_buf, SWA_KV_HEADS, SWA_HEAD_DIM), jnp.float32),
        "cache_swa_v": nrm(ks[4], (DEPTH, DEC_BATCH, w_buf, SWA_KV_HEADS, SWA_HEAD_DIM), jnp.float32),
        "norm_attn": 1.0 + 0.01 * nrm(ks[5], (DEPTH, D_MODEL), jnp.float32),
        "w_in": nrm(ks[6], (DEPTH, D_MODEL, IN_COLS), jnp.float32) * D_MODEL ** -0.5,
        "w_gk2": nrm(ks[7], (DEPTH, GATE_RANK, GLA_QK), jnp.float32) * GATE_RANK ** -0.5,
        "b_gk2": 0.1 * nrm(ks[8], (DEPTH, GLA_QK), jnp.float32),
        "gla_norm": 1.0 + 0.01 * nrm(ks[9], (DEPTH, GLA_DV), jnp.float32),
        "attn_sinks": 0.5 * nrm(ks[10], (DEPTH, SWA_HEADS), jnp.float32),
        "w_o": nrm(ks[11], (DEPTH, MIX_WIDTH, D_MODEL), jnp.float32) * MIX_WIDTH ** -0.5,
        "norm_ffn": 1.0 + 0.01 * nrm(ks[12], (DEPTH, D_MODEL), jnp.float32),
        "w_gate": nrm(ks[13], (DEPTH, D_MODEL, D_FF), jnp.float32) * D_MODEL ** -0.5,
        "w_up": nrm(ks[14], (DEPTH, D_MODEL, D_FF), jnp.float32) * D_MODEL ** -0.5,
        "w_down": nrm(ks[15], (DEPTH, D_FF, D_MODEL), jnp.float32) * D_FF ** -0.5,
        "norm_final": 1.0 + 0.01 * nrm(ks[16], (D_MODEL,), jnp.float32),
    }


def reference(x_prompt, x_sample, state_gla, cache_swa_k, cache_swa_v, norm_attn, w_in, w_gk2,
              b_gk2, gla_norm, attn_sinks, w_o, norm_ffn, w_gate, w_up, w_down, norm_final):
    pos_p = jnp.arange(x_prompt.shape[1])
    pos_s = PAST_LEN + jnp.arange(x_sample.shape[1])
    yp, ys = x_prompt, x_sample
    Sp_l, kp_l, vp_l, Ss_l, ks_l, vs_l = [], [], [], [], [], []
    for l in range(DEPTH):
        w = (norm_attn[l], w_in[l], w_gk2[l], b_gk2[l], gla_norm[l], attn_sinks[l], w_o[l],
             norm_ffn[l], w_gate[l], w_up[l], w_down[l])
        S0 = jnp.zeros((yp.shape[0], GLA_HEADS, GLA_DK, GLA_DV), jnp.float32)
        yp, Sp, kp, vp = _layer(yp, pos_p, S0, _swa_prompt, *w)
        attend_s = functools.partial(_swa_sample, kbuf=cache_swa_k[l], vbuf=cache_swa_v[l])
        ys, Ss, kss, vss = _layer(ys, pos_s, state_gla[l], attend_s, *w)
        Sp_l.append(Sp.astype(state_gla.dtype)); kp_l.append(kp.astype(cache_swa_k.dtype))
        vp_l.append(vp.astype(cache_swa_v.dtype)); Ss_l.append(Ss.astype(state_gla.dtype))
        ks_l.append(kss.astype(cache_swa_k.dtype)); vs_l.append(vss.astype(cache_swa_v.dtype))
    y_prompt = _rmsnorm(yp, norm_final)
    y_sample = _rmsnorm(ys, norm_final)
    return (y_prompt, y_sample, jnp.stack(Sp_l), jnp.stack(kp_l), jnp.stack(vp_l),
            jnp.stack(Ss_l), jnp.stack(ks_l), jnp.stack(vs_l))
```

```cpp
#include <hip/hip_runtime.h>
#include <hip/hip_bf16.h>
#include <hip/hip_cooperative_groups.h>
#include <cstdio>
namespace cg = cooperative_groups;

#ifndef MULTI_LAUNCH
#define MULTI_LAUNCH 0
#endif

typedef unsigned short bfraw;
using bf16x8 = __attribute__((ext_vector_type(8))) short;
using f32x4  = __attribute__((ext_vector_type(4))) float;
#define DEVI __device__ __forceinline__
#define LAS __attribute__((address_space(3)))

constexpr int M_TOK = 16896, MP = 16384, DM = 1024, ZC = 2304, NINP = 2560, DFF = 2816, SEQ = 8192;
constexpr int NPHASE = 38;
constexpr int ZTP = M_TOK + 64;
constexpr float EPS = 1e-6f;

constexpr size_t O_YP = 0, O_PSG = 17301504, O_PCK = 17563648, O_PCV = 17694720,
                 O_SSG = 17825792, O_SCK = 34603008, O_SCV = 42991616;

struct Params {
  const float *x_prompt, *x_sample, *state_gla, *cache_k, *cache_v, *norm_attn, *w_in, *w_gk2, *b_gk2,
              *gla_norm, *sinks, *w_o, *norm_ffn, *w_gate, *w_up, *w_down, *norm_final;
  float* out;
  bfraw *WinT, *WoT, *WguT, *WdT, *xb, *zh, *ocat, *zT;
  float *ssq, *ga, *U, *dn, *bbuf;
  bfraw* Sp;
  float2* rope;
  unsigned* bar;
  unsigned* qctr;
};

DEVI int lane_id() { int l; asm volatile("v_mbcnt_lo_u32_b32 %0, -1, 0\n\tv_mbcnt_hi_u32_b32 %0, -1, %0" : "=v"(l)); return l; }
DEVI int otid512() { const int w = __builtin_amdgcn_readfirstlane((int)(threadIdx.x >> 6)); return w * 64 + lane_id(); }
DEVI int otid() { return otid512() & 255; }
struct HalfBar { volatile LAS unsigned* cnt; unsigned target; };
DEVI void half_sync(HalfBar& hb) {
  asm volatile("s_waitcnt lgkmcnt(0)" ::: "memory");
  hb.target += 4u;
  if (lane_id() == 0) __hip_atomic_fetch_add((LAS unsigned*)hb.cnt, 1u, __ATOMIC_RELAXED, __HIP_MEMORY_SCOPE_WORKGROUP);
  while (*hb.cnt < hb.target) __builtin_amdgcn_s_sleep(0);
  asm volatile("s_waitcnt lgkmcnt(0)" ::: "memory");
}
DEVI float4 ntld4(const float* p) { const f32x4 v = __builtin_nontemporal_load((const f32x4*)p); return make_float4(v[0], v[1], v[2], v[3]); }
DEVI void ntst4(float4 v, float* p) { f32x4 w = {v.x, v.y, v.z, v.w}; __builtin_nontemporal_store(w, (f32x4*)p); }
DEVI float shx(float v, int mask) { const int l = lane_id(); return __int_as_float(__builtin_amdgcn_ds_bpermute((l ^ mask) << 2, __float_as_int(v))); }
DEVI bfraw f2bf(float f) { unsigned u = __float_as_uint(f); u += 0x7fffu + ((u >> 16) & 1u); return (bfraw)(u >> 16); }
DEVI float bf2f(bfraw h) { return __uint_as_float(((unsigned)h) << 16); }
typedef __bf16 bf16v2_t __attribute__((ext_vector_type(2)));
typedef float f32v2_t __attribute__((ext_vector_type(2)));
DEVI unsigned pack2(float a, float b) { f32v2_t v = {a, b}; bf16v2_t r = __builtin_convertvector(v, bf16v2_t); return __builtin_bit_cast(unsigned, r); }
DEVI float sum16(float v) { v += shx(v, 1); v += shx(v, 2); v += shx(v, 4); v += shx(v, 8); return v; }
DEVI float max16(float v) { v = fmaxf(v, shx(v, 1)); v = fmaxf(v, shx(v, 2)); v = fmaxf(v, shx(v, 4)); v = fmaxf(v, shx(v, 8)); return v; }
DEVI float sum64(float v) { v = sum16(v); v += shx(v, 16); v += shx(v, 32); return v; }
DEVI float silu_f(float x) { return __fdividef(x, 1.f + __expf(-x)); }
DEVI float logsig(float x) { return fminf(x, 0.f) - __logf(1.f + __expf(-fabsf(x))); }
DEVI void unpack8(uint4 u, float* f) {
  f[0] = __uint_as_float(u.x << 16); f[1] = __uint_as_float(u.x & 0xffff0000u);
  f[2] = __uint_as_float(u.y << 16); f[3] = __uint_as_float(u.y & 0xffff0000u);
  f[4] = __uint_as_float(u.z << 16); f[5] = __uint_as_float(u.z & 0xffff0000u);
  f[6] = __uint_as_float(u.w << 16); f[7] = __uint_as_float(u.w & 0xffff0000u);
}


#define XB_TMO      128
#define XB_XCNT(j)  (256  + 64 * (j))
#define XB_XSUB(j)  (1280 + 64 * (j))
#define XB_XGEN(j)  (2304 + 64 * (j))
#define XB_TOP      3328
#define XB_TOPGEN   3392
#define XCD_BAR_WORDS 3456
#define XB_SPIN_CAP (1u << 22)
DEVI unsigned xb_ld(unsigned* p)              { return __hip_atomic_load(p, __ATOMIC_RELAXED, __HIP_MEMORY_SCOPE_AGENT); }
DEVI unsigned xb_add(unsigned* p, unsigned v) { return __hip_atomic_fetch_add(p, v, __ATOMIC_RELAXED, __HIP_MEMORY_SCOPE_AGENT); }
DEVI unsigned xb_xcc_id() { return (unsigned)__builtin_amdgcn_s_getreg((3 << 11) | 20) & 0xFu; }
#define XB_SPIN(cond, bar) do { unsigned _sp = 0; while (cond) { __builtin_amdgcn_s_sleep(1); \
    if ((++_sp & 255u) == 0u) { if (xb_ld(&(bar)[XB_TMO])) break; if (_sp > XB_SPIN_CAP) { atomicAdd(&(bar)[XB_TMO], 1u); break; } } } } while (0)
struct XcdBarrier { unsigned* bar; unsigned x; volatile LAS unsigned* st; };
DEVI XcdBarrier xcd_barrier_post(unsigned* bar, volatile LAS unsigned* st) {
  XcdBarrier b; b.bar = bar; b.x = xb_xcc_id(); b.st = st;
  if (otid512() == 0) (void)xb_add(&bar[XB_XCNT(b.x)], 1u);
  return b;
}
DEVI void xcd_barrier_complete(unsigned* bar, unsigned x, unsigned& nloc, unsigned& nx) {
  const unsigned G = gridDim.x * gridDim.y * gridDim.z;
  unsigned sum, cnt, mine, sp = 0u;
  for (;;) {
    sum = 0u; cnt = 0u; mine = 0u;
#pragma unroll
    for (unsigned j = 0; j < 16; ++j) { const unsigned c = xb_ld(&bar[XB_XCNT(j)]); sum += c; cnt += (c > 0u) ? 1u : 0u; mine = (j == x) ? c : mine; }
    if (sum == G) break;
    __builtin_amdgcn_s_sleep(1);
    if ((++sp & 255u) == 0u) { if (xb_ld(&bar[XB_TMO])) break; if (sp > XB_SPIN_CAP) { atomicAdd(&bar[XB_TMO], 1u); break; } }
  }
  nloc = mine > 0u ? mine : 1u; nx = cnt > 0u ? cnt : 1u;
}
DEVI void xcd_barrier(const XcdBarrier& b) {
  asm volatile("s_waitcnt vmcnt(0)" ::: "memory");
  __syncthreads();
  if (otid512() == 0) {
    unsigned* bar = b.bar;
    __builtin_amdgcn_s_waitcnt(0);
    unsigned nloc = b.st[0], nx = b.st[1];
    if (nloc == 0u) { xcd_barrier_complete(bar, b.x, nloc, nx); b.st[0] = nloc; b.st[1] = nx; }
    const unsigned old = xb_add(&bar[XB_XSUB(b.x)], 1u);
    const unsigned gen = old / nloc;
    if (old + 1u == (gen + 1u) * nloc) {
      __builtin_amdgcn_fence(__ATOMIC_RELEASE, "agent");
      asm volatile("s_waitcnt vmcnt(0)" ::: "memory");
      const unsigned og = xb_add(&bar[XB_TOP], 1u);
      const unsigned tg = og / nx;
      if (og + 1u == (tg + 1u) * nx) xb_add(&bar[XB_TOPGEN], 1u);
      else XB_SPIN(xb_ld(&bar[XB_TOPGEN]) == tg, bar);
      __builtin_amdgcn_fence(__ATOMIC_ACQUIRE, "agent");
      xb_add(&bar[XB_XGEN(b.x)], 1u);
      asm volatile("s_waitcnt vmcnt(0)" ::: "memory");
    } else {
      XB_SPIN(xb_ld(&bar[XB_XGEN(b.x)]) == gen, bar);
      __builtin_amdgcn_fence(__ATOMIC_ACQUIRE, "agent");
      asm volatile("s_waitcnt vmcnt(0)" ::: "memory");
    }
  }
  __syncthreads();
}

DEVI float4 wsrc4(const Params& p, int type, int l, int k, int r) {
  float4 v; float sc = 1.f;
  if (type == 0) {
    const int q = r & 63;
    const int n = (r & ~63) + ((q >> 5) << 4) + (q & 15) + (((q >> 4) & 1) << 5);
    int col;
    if (n < 1024) col = n; else if (n < 2304) col = n + 16; else if (n < 2320) col = n - 1280; else return make_float4(0.f, 0.f, 0.f, 0.f);
    sc = p.norm_attn[l * 1024 + k];
    if (n < 256 || (n >= 1536 && n < 2048)) sc *= 0.125f;
    v = ntld4(p.w_in + ((size_t)l * 1024 + k) * 2320 + col);
  } else if (type == 1) {
    v = ntld4(p.w_o + ((size_t)l * 1024 + k) * 1024 + r);
  } else if (type == 2) {
    const int G = r >> 5, t = r & 31;
    const float* s = (t < 16) ? p.w_gate : p.w_up;
    sc = p.norm_ffn[l * 1024 + k];
    v = ntld4(s + ((size_t)l * 1024 + k) * 2816 + G * 16 + (t & 15));
  } else {
    v = ntld4(p.w_down + ((size_t)l * 2816 + k) * 1024 + r);
  }
  v.x *= sc; v.y *= sc; v.z *= sc; v.w *= sc;
  return v;
}

DEVI void transpose_item(const Params& p, int it, unsigned char* smem) {
  float* t = (float*)smem;
  const int tid = otid();
  int l = it / 3008, r = it % 3008;
  int type, ntile, ktile, K; bfraw* dst;
  if (r < 640) { type = 0; ntile = r / 16; ktile = r % 16; K = 1024; dst = p.WinT + (size_t)l * NINP * 1024; }
  else if (r < 896) { r -= 640; type = 1; ntile = r / 16; ktile = r % 16; K = 1024; dst = p.WoT + (size_t)l * 1024 * 1024; }
  else if (r < 2304) { r -= 896; type = 2; ntile = r / 16; ktile = r % 16; K = 1024; dst = p.WguT + (size_t)l * 5632 * 1024; }
  else { r -= 2304; type = 3; ntile = r / 44; ktile = r % 44; K = 2816; dst = p.WdT + (size_t)l * 1024 * 2816; }
  const int n0 = ntile * 64, k0 = ktile * 64;
  __syncthreads();
  {
    const int nq = (tid & 15) * 4, kb = tid >> 4;
    float4 v[4];
#pragma unroll
    for (int i = 0; i < 4; ++i) v[i] = wsrc4(p, type, l, k0 + kb + 16 * i, n0 + nq);
#pragma unroll
    for (int i = 0; i < 4; ++i) {
      float* tp = t + (kb + 16 * i) * 65 + nq;
      tp[0] = v[i].x; tp[1] = v[i].y; tp[2] = v[i].z; tp[3] = v[i].w;
    }
  }
  __syncthreads();
  {
    const int kc = tid & 7;
#pragma unroll
    for (int i = 0; i < 2; ++i) {
      int nn = (tid >> 3) + 32 * i;
      float v[8];
#pragma unroll
      for (int e = 0; e < 8; ++e) v[e] = t[(kc * 8 + e) * 65 + nn];
      uint4 o; o.x = pack2(v[0], v[1]); o.y = pack2(v[2], v[3]); o.z = pack2(v[4], v[5]); o.w = pack2(v[6], v[7]);
      { typedef unsigned u32x4_t __attribute__((ext_vector_type(4))); u32x4_t ov = {o.x, o.y, o.z, o.w}; __builtin_nontemporal_store(ov, (u32x4_t*)(dst + (size_t)(n0 + nn) * K + k0 + kc * 8)); }
    }
  }
}

DEVI void xconv_item(const Params& p, int it) {
  const int tid = otid(), lane = tid & 63, w = tid >> 6;
#pragma unroll 1
  for (int ps = 0; ps < 4; ++ps) {
    int m = it * 16 + ps * 4 + w;
    const float* src = (m < MP) ? (p.x_prompt + (size_t)m * 1024) : (p.x_sample + (size_t)(m - MP) * 1024);
    float ss = 0.f;
#pragma unroll
    for (int i = 0; i < 4; ++i) {
      int c = lane * 4 + i * 256;
      float4 v = ntld4(src + c);
      uint2 o; o.x = pack2(v.x, v.y); o.y = pack2(v.z, v.w);
      *(uint2*)(p.xb + (size_t)m * 1024 + c) = o;
      ss += v.x * v.x + v.y * v.y + v.z * v.z + v.w * v.w;
    }
    ss = sum64(ss);
    if (lane < 16) p.ssq[(size_t)m * 16 + lane] = (lane == 0) ? ss : 0.f;
  }
}

DEVI void rope_item(const Params& p, int it) {
  int idx = it * 256 + otid();
  if (idx < 8196 * 32) {
    int pos = idx >> 5, i = idx & 31;
    float inv = exp2f(-(float)i * 0.41524101186092029f);
    float ang = (float)pos * inv;
    double rev = (double)ang * 0.15915494309189535;
    rev -= rint(rev);
    float rf = (float)(rev * 6.283185307179586);
    p.rope[idx] = make_float2(__cosf(rf), __sinf(rf));
  }
}

DEVI void phase_prologue(const Params& p, unsigned char* smem, int vb, int nvb) {
  const int nT = 3008, nX = M_TOK / 16, nR = 1026;
  const int total = nT + nX + nR;
  for (int it = vb; it < total; it += nvb) {
    if (it < nT) transpose_item(p, it, smem);
    else if (it < nT + nX) xconv_item(p, it - nT);
    else rope_item(p, it - nT - nX);
  }
}

enum { EPI_IN = 0, EPI_RES = 1, EPI_GU = 2, EPI_PART = 3 };
constexpr int GBK = 64, GHALF = 128, GHT = GHALF * GBK;

DEVI int lds_byte(int r, int c) {
  int st = (r >> 4) * 2 + (c >> 5), rr = r & 15, cc = c & 31, ob = rr * 64 + cc * 2;
  return st * 1024 + (ob ^ (((ob >> 9) & 1) << 5));
}
DEVI void stage_rc(int b, int& R, int& C) {
  int st = b / 1024, sb = b % 1024, swz = sb ^ (((sb >> 9) & 1) << 5);
  R = (st >> 1) * 16 + swz / 64; C = (st & 1) * 32 + (swz % 64) / 2;
}

template <int EPI>
DEVI void gemm_unit(const Params& p, int l, const bfraw* A, const bfraw* Bt, const int LD, const int K,
                    const int pm, const int pn, unsigned char* smem, float* part) {
  LAS bfraw* shm = (LAS bfraw*)smem;
  float* sR = (float*)(smem + 131072);
  const int tid = otid512();
#define SA(b, h) (shm + ((b) * 2 + (h)) * GHT)
#define SB(b, h) (shm + (4 + (b) * 2 + (h)) * GHT)
#define STAGE(P, BASE, br, kt) do { const char* _ub = (const char*)((BASE) + (long)(br) * LD + (long)(kt) * GBK); \
    __builtin_amdgcn_global_load_lds((const unsigned*)(_ub + voff0), (LAS unsigned*)((LAS char*)(P) + wvb), 16, 0, 0); \
    __builtin_amdgcn_global_load_lds((const unsigned*)(_ub + voff1), (LAS unsigned*)((LAS char*)(P) + wvb + 8192), 16, 0, 0); } while (0)
#define LDA(dst, b, h) _Pragma("unroll") for (int m = 0; m < 4; ++m) _Pragma("unroll") for (int k = 0; k < 2; ++k) \
    dst[m][k] = *reinterpret_cast<const LAS bf16x8*>((const LAS char*)SA(b, h) + lds_byte(wr * 64 + m * 16 + fr, k * 32 + fq * 8))
#define LDB(dst, b, h) _Pragma("unroll") for (int n = 0; n < 2; ++n) _Pragma("unroll") for (int k = 0; k < 2; ++k) \
    dst[n][k] = *reinterpret_cast<const LAS bf16x8*>((const LAS char*)SB(b, h) + lds_byte(wc * 32 + n * 16 + fr, k * 32 + fq * 8))
#define MMA(ai, bj, At, Bq) do { __builtin_amdgcn_s_setprio(1); \
    _Pragma("unroll") for (int m = 0; m < 4; ++m) _Pragma("unroll") for (int n = 0; n < 2; ++n) _Pragma("unroll") for (int k = 0; k < 2; ++k) \
      acc[ai][bj][m][n] = __builtin_amdgcn_mfma_f32_16x16x32_bf16(Bq[n][k], At[m][k], acc[ai][bj][m][n], 0, 0, 0); \
    __builtin_amdgcn_s_setprio(0); } while (0)
#define WAIT_V(n) asm volatile("s_waitcnt vmcnt(" #n ")" ::: "memory")
#define WAIT_L(n) asm volatile("s_waitcnt lgkmcnt(" #n ")" ::: "memory")
#define BAR __builtin_amdgcn_s_barrier()
#define SCHED __builtin_amdgcn_sched_barrier(0)

  const int brow = pm * 256, bcol = pn * 256;
  const int wvb = __builtin_amdgcn_readfirstlane(tid >> 6) * 1024;
  unsigned voff0, voff1;
  { int _r, _c; stage_rc(tid * 16, _r, _c); voff0 = (unsigned)(_r * LD + _c) * 2u; stage_rc(tid * 16 + 8192, _r, _c); voff1 = (unsigned)(_r * LD + _c) * 2u; }
  const int wid = tid >> 6, lane = tid & 63, wr = wid >> 2, wc = wid & 3, fr = lane & 15, fq = lane >> 4;
  __syncthreads();
  if (EPI == EPI_IN || EPI == EPI_GU) {
    if (tid < 256) {
      const float4* q = (const float4*)(p.ssq + (size_t)(brow + tid) * 16);
      float4 a = q[0], b = q[1], c = q[2], d = q[3];
      float s = ((a.x + a.y) + (a.z + a.w)) + ((b.x + b.y) + (b.z + b.w)) + ((c.x + c.y) + (c.z + c.w)) + ((d.x + d.y) + (d.z + d.w));
      sR[tid] = rsqrtf(s * (1.f / 1024.f) + EPS);
    }
  }
  WAIT_V(0);
  f32x4 acc[2][2][4][2];
#pragma unroll
  for (int a = 0; a < 2; ++a)
#pragma unroll
    for (int b = 0; b < 2; ++b)
#pragma unroll
      for (int m = 0; m < 4; ++m)
#pragma unroll
        for (int n = 0; n < 2; ++n) acc[a][b][m][n] = (f32x4){0.f, 0.f, 0.f, 0.f};
  bf16x8 At[4][2], B0[2][2], B1[2][2];
  const int nt = K / GBK;
  STAGE(SB(0, 0), Bt, bcol, 0); STAGE(SA(0, 0), A, brow, 0);
  STAGE(SB(0, 1), Bt, bcol + GHALF, 0); STAGE(SA(0, 1), A, brow + GHALF, 0);
  if (wr == 1) BAR;
  WAIT_V(4); BAR;
  STAGE(SB(1, 0), Bt, bcol, 1); STAGE(SA(1, 0), A, brow, 1); STAGE(SB(1, 1), Bt, bcol + GHALF, 1);
  WAIT_V(6); BAR;
#pragma unroll 1
  for (int t = 0; t < nt - 2; t += 2) {
    LDB(B0, 0, 0); SCHED; LDA(At, 0, 0); STAGE(SA(1, 1), A, brow + GHALF, t + 1);
    WAIT_L(8); BAR; WAIT_L(0); MMA(0, 0, At, B0); BAR; SCHED;
    LDB(B1, 0, 1); STAGE(SB(0, 0), Bt, bcol, t + 2);
    BAR; WAIT_L(0); MMA(0, 1, At, B1); BAR;
    LDA(At, 0, 1); STAGE(SA(0, 0), A, brow, t + 2);
    BAR; WAIT_L(0); MMA(1, 0, At, B0); BAR; SCHED;
    STAGE(SB(0, 1), Bt, bcol + GHALF, t + 2);
    WAIT_V(6); BAR; MMA(1, 1, At, B1); BAR;
    LDB(B0, 1, 0); SCHED; LDA(At, 1, 0); STAGE(SA(0, 1), A, brow + GHALF, t + 2);
    WAIT_L(8); BAR; WAIT_L(0); MMA(0, 0, At, B0); BAR; SCHED;
    LDB(B1, 1, 1); STAGE(SB(1, 0), Bt, bcol, t + 3);
    BAR; WAIT_L(0); MMA(0, 1, At, B1); BAR;
    LDA(At, 1, 1); STAGE(SA(1, 0), A, brow, t + 3);
    BAR; WAIT_L(0); MMA(1, 0, At, B0); BAR; SCHED;
    STAGE(SB(1, 1), Bt, bcol + GHALF, t + 3);
    WAIT_V(6); BAR; MMA(1, 1, At, B1); BAR;
  }
  { LDB(B0, 0, 0); LDA(At, 0, 0); STAGE(SA(1, 1), A, brow + GHALF, nt - 1);
    BAR; WAIT_L(0); MMA(0, 0, At, B0); BAR;
    LDB(B1, 0, 1); BAR; WAIT_L(0); MMA(0, 1, At, B1); BAR;
    LDA(At, 0, 1); WAIT_V(4); BAR; WAIT_L(0); MMA(1, 0, At, B0); MMA(1, 1, At, B1); BAR; }
  { LDB(B0, 1, 0); LDA(At, 1, 0); WAIT_V(2); BAR; WAIT_L(0); MMA(0, 0, At, B0); BAR;
    LDB(B1, 1, 1); WAIT_V(0); BAR; WAIT_L(0); MMA(0, 1, At, B1); BAR;
    LDA(At, 1, 1); BAR; WAIT_L(0); MMA(1, 0, At, B0); MMA(1, 1, At, B1); BAR; }
  if (wr == 0) BAR;
#undef SA
#undef SB
#undef STAGE
#undef LDA
#undef LDB
#undef MMA
#undef WAIT_V
#undef WAIT_L
#undef BAR
#undef SCHED

  if (EPI == EPI_IN) {
    bfraw* z = p.zh;
#pragma unroll
    for (int bj = 0; bj < 2; ++bj) {
      const int tc = bcol + bj * 128 + (wc >> 1) * 64 + (wc & 1) * 16 + fq * 4;
      const bool rope = (tc >= 1536) && (tc < 2176);
      const bool isga = (tc >= 2304);
      const int trow = (tc >= 256 && tc < 1024) ? (tc - 256) : ((tc >= 2176 && tc < 2304) ? (768 + tc - 2176) : -1);
#pragma unroll
      for (int ai = 0; ai < 2; ++ai)
#pragma unroll
        for (int m = 0; m < 4; ++m) {
          const int rl = ai * 128 + wr * 64 + m * 16 + fr;
          const int mrow = brow + rl;
          const float rs = sR[rl];
          f32x4 x1 = acc[ai][bj][m][0] * rs, x2 = acc[ai][bj][m][1] * rs;
          if (isga) {
            if (tc < 2320) *(f32x4*)(p.ga + (size_t)mrow * 16 + (tc - 2304)) = x1;
          } else {
            if (rope) {
              const int pos = (mrow < MP) ? (mrow & (SEQ - 1)) : (SEQ + ((mrow - MP) & 3));
              const float4* cp = (const float4*)(p.rope + pos * 32 + (tc & 31));
              const float4 c01 = cp[0], c23 = cp[1];
              f32x4 y1, y2;
              y1[0] = x1[0] * c01.x - x2[0] * c01.y; y2[0] = x2[0] * c01.x + x1[0] * c01.y;
              y1[1] = x1[1] * c01.z - x2[1] * c01.w; y2[1] = x2[1] * c01.z + x1[1] * c01.w;
              y1[2] = x1[2] * c23.x - x2[2] * c23.y; y2[2] = x2[2] * c23.x + x1[2] * c23.y;
              y1[3] = x1[3] * c23.z - x2[3] * c23.w; y2[3] = x2[3] * c23.z + x1[3] * c23.w;
              x1 = y1; x2 = y2;
            }
            uint2 o1, o2;
            o1.x = pack2(x1[0], x1[1]); o1.y = pack2(x1[2], x1[3]);
            o2.x = pack2(x2[0], x2[1]); o2.y = pack2(x2[2], x2[3]);
            *(uint2*)(z + (size_t)mrow * ZC + tc) = o1;
            *(uint2*)(z + (size_t)mrow * ZC + tc + 32) = o2;
            if (trow >= 0) {
              bfraw* zt = p.zT + (size_t)trow * ZTP + mrow;
              zt[0] = (bfraw)(o1.x & 0xffffu); zt[(size_t)ZTP] = (bfraw)(o1.x >> 16);
              zt[(size_t)2 * ZTP] = (bfraw)(o1.y & 0xffffu); zt[(size_t)3 * ZTP] = (bfraw)(o1.y >> 16);
              zt[(size_t)32 * ZTP] = (bfraw)(o2.x & 0xffffu); zt[(size_t)33 * ZTP] = (bfraw)(o2.x >> 16);
              zt[(size_t)34 * ZTP] = (bfraw)(o2.y & 0xffffu); zt[(size_t)35 * ZTP] = (bfraw)(o2.y >> 16);
            }
          }
        }
    }
  } else if (EPI == EPI_RES) {
#pragma unroll
    for (int ai = 0; ai < 2; ++ai)
#pragma unroll
      for (int m = 0; m < 4; ++m) {
        const int mrow = brow + ai * 128 + wr * 64 + m * 16 + fr;
        float ss = 0.f;
#pragma unroll
        for (int bj = 0; bj < 2; ++bj)
#pragma unroll
          for (int n = 0; n < 2; ++n) {
            const size_t idx = (size_t)mrow * 1024 + bcol + bj * 128 + wc * 32 + n * 16 + fq * 4;
            const uint2 xr = *(const uint2*)(p.xb + idx);
            f32x4 v = acc[ai][bj][m][n];
            v[0] += __uint_as_float(xr.x << 16); v[1] += __uint_as_float(xr.x & 0xffff0000u);
            v[2] += __uint_as_float(xr.y << 16); v[3] += __uint_as_float(xr.y & 0xffff0000u);
            uint2 o; o.x = pack2(v[0], v[1]); o.y = pack2(v[2], v[3]);
            *(uint2*)(p.xb + idx) = o;
            ss += v[0] * v[0] + v[1] * v[1] + v[2] * v[2] + v[3] * v[3];
          }
        ss += shx(ss, 16); ss += shx(ss, 32);
        if (fq == 0) p.ssq[(size_t)mrow * 16 + pn * 4 + wc] = ss;
      }
  } else if (EPI == EPI_PART) {
#pragma unroll
    for (int ai = 0; ai < 2; ++ai)
#pragma unroll
      for (int m = 0; m < 4; ++m) {
        const int r = brow - MP + ai * 128 + wr * 64 + m * 16 + fr;
#pragma unroll
        for (int bj = 0; bj < 2; ++bj)
#pragma unroll
          for (int n = 0; n < 2; ++n)
            *(f32x4*)(part + (size_t)r * 1024 + bcol + bj * 128 + wc * 32 + n * 16 + fq * 4) = acc[ai][bj][m][n];
      }
  } else {
    bfraw* hid = p.zh;
#pragma unroll
    for (int bj = 0; bj < 2; ++bj) {
      const int hc = 16 * (8 * pn + 4 * bj + wc) + fq * 4;
#pragma unroll
      for (int ai = 0; ai < 2; ++ai)
#pragma unroll
        for (int m = 0; m < 4; ++m) {
          const int rl = ai * 128 + wr * 64 + m * 16 + fr;
          const float rs = sR[rl];
          const f32x4 g = acc[ai][bj][m][0] * rs, u = acc[ai][bj][m][1] * rs;
          uint2 o;
          o.x = pack2(silu_f(g[0]) * u[0], silu_f(g[1]) * u[1]);
          o.y = pack2(silu_f(g[2]) * u[2], silu_f(g[3]) * u[3]);
          *(uint2*)(hid + (size_t)(brow + rl) * DFF + hc) = o;
        }
    }
  }
}

DEVI void unit_from_list(int L, int NU, int& pm, int& pn) {
  const int full = 64 * NU;
  if (L < full) { const int g = L / (4 * NU), rem = L - g * 4 * NU; pn = rem >> 2; pm = g * 4 + (rem & 3); }
  else { const int r = L - full; pn = r >> 1; pm = 64 + (r & 1); }
}
template <int EPI>
DEVI void gemm_phase(const Params& p, int l, const bfraw* A, const bfraw* Bt, int K, int NU, unsigned char* smem, unsigned* qctr, int qlo, int qhi) {
  const int nunits = (M_TOK / 256) * NU;
  const int x = blockIdx.x & 7, j = blockIdx.x >> 3, nj = gridDim.x >> 3;
  const int chunk = (nunits + 7) >> 3;
  const int lo = x * chunk, hi = (lo + chunk < nunits) ? lo + chunk : nunits;
  for (int L = lo + j; L < hi; L += nj) {
    int pm, pn;
    unit_from_list(L, NU, pm, pn);
    gemm_unit<EPI>(p, l, A, Bt, K, K, pm, pn, smem, nullptr);
  }
  if (qctr) {
    volatile unsigned* sQ = (volatile unsigned*)(smem + 2 * 73728 - 96);
    const int t512 = otid512(), vh = (t512 >> 8) & 1;
    for (;;) {
      __syncthreads();
      if (t512 == 0) *sQ = __hip_atomic_fetch_add(qctr, 2u, __ATOMIC_RELAXED, __HIP_MEMORY_SCOPE_AGENT);
      __syncthreads();
      const int base = qlo + (int)*sQ;
      if (base >= qhi) break;
      transpose_item(p, base + vh, smem + vh * 73728);
    }
  }
}
DEVI void gemm_res_phase(const Params& p, int l, const bfraw* A, const bfraw* Bt, int K, int nsplit, unsigned char* smem) {
  const int x = blockIdx.x & 7, j = blockIdx.x >> 3, nj = gridDim.x >> 3;
  for (int L = x * 32 + j; L < x * 32 + 32; L += nj) {
    int pm, pn;
    unit_from_list(L, 4, pm, pn);
    gemm_unit<EPI_RES>(p, l, A, Bt, K, K, pm, pn, smem, nullptr);
  }
  for (int q = j; q < nsplit; q += nj) {
    const int piece = x * nsplit + q, su = piece / nsplit, ks = piece - su * nsplit;
    gemm_unit<EPI_PART>(p, l, A + ks * 256, Bt + ks * 256, K, 256, 64 + (su >> 2), su & 3, smem, p.U + (size_t)ks * 512 * 1024);
  }
}
template <int NS>
DEVI void fin_wave(const Params& p, int wi) {
  const int lane = lane_id();
  const int r = wi >> 2, q = wi & 3, m = MP + r, c = q * 256 + lane * 4;
  const uint2 xr = *(const uint2*)(p.xb + (size_t)m * 1024 + c);
  float4 pv[NS];
#pragma unroll
  for (int ks = 0; ks < NS; ++ks) pv[ks] = *(const float4*)(p.U + ((size_t)ks * 512 + r) * 1024 + c);
  float4 v = make_float4(__uint_as_float(xr.x << 16), __uint_as_float(xr.x & 0xffff0000u), __uint_as_float(xr.y << 16), __uint_as_float(xr.y & 0xffff0000u));
#pragma unroll
  for (int ks = 0; ks < NS; ++ks) { v.x += pv[ks].x; v.y += pv[ks].y; v.z += pv[ks].z; v.w += pv[ks].w; }
  uint2 o; o.x = pack2(v.x, v.y); o.y = pack2(v.z, v.w);
  *(uint2*)(p.xb + (size_t)m * 1024 + c) = o;
  float ss = v.x * v.x + v.y * v.y + v.z * v.z + v.w * v.w;
  ss = sum64(ss);
  if (lane < 4) p.ssq[(size_t)m * 16 + q * 4 + lane] = (lane == 0) ? ss : 0.f;
}

DEVI void swa_prompt_wave(const Params& p, int l, int wi) {
  const int lane = lane_id(), fr = lane & 15, fq = lane >> 4;
  const int g = wi & 7, kvh = (wi >> 3) & 1, n = (wi >> 4) & 63, bb = wi >> 10;
  const bfraw* z = p.zh;
  const int mq0 = bb * SEQ + n * 128, r0 = g * 16;
  bf16x8 kf[10][2];
#pragma unroll
  for (int c = 0; c < 10; ++c) {
    const int il = 32 * (c >> 1) + (fr >> 2) * 8 + (c & 1) * 4 + (fr & 3);
    int tok = mq0 - 128 + r0 + il; tok = tok < 0 ? 0 : tok;
    const bfraw* kp = z + (size_t)tok * ZC + 2048 + kvh * 64 + fq * 8;
    kf[c][0] = *(const bf16x8*)(kp); kf[c][1] = *(const bf16x8*)(kp + 32);
  }
  bf16x8 vf[5][4];
  {
    const bfraw* vT = p.zT + (size_t)(768 + kvh * 64 + fr) * ZTP;
    const int tokb = mq0 - 128 + r0 + fq * 8;
#pragma unroll
    for (int pr = 0; pr < 5; ++pr) {
      int t0 = tokb + 32 * pr; t0 = t0 < 0 ? 0 : t0;
#pragma unroll
      for (int dt = 0; dt < 4; ++dt) vf[pr][dt] = *(const bf16x8*)(vT + (size_t)(dt * 16) * ZTP + t0);
    }
  }
  const bfraw* qbase = z + (size_t)(mq0 + r0 + fr) * ZC + 1536 + kvh * 256 + fq * 8;
  bf16x8 qn0 = *(const bf16x8*)(qbase), qn1 = *(const bf16x8*)(qbase + 32);
  asm volatile("" ::: "memory");
#pragma unroll 1
  for (int hq = 0; hq < 4; ++hq) {
    const int h = kvh * 4 + hq;
    const bf16x8 q0 = qn0, q1 = qn1;
    {
      const bfraw* qp = qbase + ((hq + 1) & 3) * 64;
      qn0 = *(const bf16x8*)(qp); qn1 = *(const bf16x8*)(qp + 32);
    }
    const float sink = p.sinks[l * 8 + h];
    f32x4 s[10];
#pragma unroll
    for (int c = 0; c < 10; ++c) {
      f32x4 a = (f32x4){0.f, 0.f, 0.f, 0.f};
      a = __builtin_amdgcn_mfma_f32_16x16x32_bf16(kf[c][0], q0, a, 0, 0, 0);
      a = __builtin_amdgcn_mfma_f32_16x16x32_bf16(kf[c][1], q1, a, 0, 0, 0);
      s[c] = a;
    }
    float m = -INFINITY;
#pragma unroll
    for (int c = 0; c < 10; ++c)
#pragma unroll
      for (int j = 0; j < 4; ++j) {
        const int il = 32 * (c >> 1) + fq * 8 + (c & 1) * 4 + j;
        const bool ok = (fr < il) && (il <= fr + 128) && ((n > 0) || (r0 + il >= 128));
        const float v = ok ? s[c][j] : -INFINITY;
        s[c][j] = v;
        m = fmaxf(m, v);
      }
    m = fmaxf(m, shx(m, 16)); m = fmaxf(m, shx(m, 32));
    m = fmaxf(m, sink);
    float sm = 0.f;
#pragma unroll
    for (int c = 0; c < 10; ++c)
#pragma unroll
      for (int j = 0; j < 4; ++j) { const float pv = __expf(s[c][j] - m); s[c][j] = pv; sm += pv; }
    sm += shx(sm, 16); sm += shx(sm, 32);
    const float inv = 1.f / (sm + __expf(sink - m));
    f32x4 o[4];
#pragma unroll
    for (int dt = 0; dt < 4; ++dt) o[dt] = (f32x4){0.f, 0.f, 0.f, 0.f};
#pragma unroll
    for (int pr = 0; pr < 5; ++pr) {
      union { bf16x8 v; unsigned u[4]; } pb;
      pb.u[0] = pack2(s[2 * pr][0], s[2 * pr][1]); pb.u[1] = pack2(s[2 * pr][2], s[2 * pr][3]);
      pb.u[2] = pack2(s[2 * pr + 1][0], s[2 * pr + 1][1]); pb.u[3] = pack2(s[2 * pr + 1][2], s[2 * pr + 1][3]);
#pragma unroll
      for (int dt = 0; dt < 4; ++dt) o[dt] = __builtin_amdgcn_mfma_f32_16x16x32_bf16(vf[pr][dt], pb.v, o[dt], 0, 0, 0);
    }
    bfraw* op = p.ocat + (size_t)(mq0 + r0 + fr) * 1024 + 512 + h * 64 + fq * 4;
#pragma unroll
    for (int dt = 0; dt < 4; ++dt) {
      uint2 u; u.x = pack2(o[dt][0] * inv, o[dt][1] * inv); u.y = pack2(o[dt][2] * inv, o[dt][3] * inv);
      *(uint2*)(op + dt * 16) = u;
    }
  }
}
DEVI void prompt_cache_copy(const Params& p, int l, int vb, int nvb) {
  const int tid = otid();
  for (int idx = vb * 256 + tid; idx < 2 * 128 * 2 * 64 * 2; idx += nvb * 256) {
    const int d = idx & 63, kvh = (idx >> 6) & 1, w = (idx >> 7) & 127, bb = (idx >> 14) & 1, isv = idx >> 15;
    const float v = bf2f(p.zh[(size_t)(bb * SEQ + SEQ - 128 + w) * ZC + (isv ? 2176 : 2048) + kvh * 64 + d]);
    p.out[(isv ? O_PCV : O_PCK) + ((((size_t)l * 2 + bb) * 128 + w) * 2 + kvh) * 64 + d] = v;
  }
}

DEVI void swa_sample_item(const Params& p, int l, int it, unsigned char* smem, HalfBar& hb) {
  const int tid = otid();
  const int kvh = it & 1, bs = it >> 1;
  const bfraw* z = p.zh;
  float* Ks = (float*)smem;
  float* Qs = (float*)(smem + 34560);
  float* Ss = (float*)(smem + 34560 + 4096);
  float* Rd = (float*)(smem + 34560 + 4096 + 8448);
  const int mrow0 = MP + bs * 4;
  half_sync(hb);
  {
    const int sub = tid & 15, i0 = tid >> 4;
    float4 kreg[9];
#pragma unroll
    for (int j = 0; j < 8; ++j) kreg[j] = ntld4(p.cache_k + ((((size_t)l * 128 + bs) * 128 + i0 + 16 * j) * 2 + kvh) * 64 + sub * 4);
    {
      const uint2 u = *(const uint2*)(z + (size_t)(mrow0 + (i0 & 3)) * ZC + 2048 + kvh * 64 + sub * 4);
      kreg[8] = make_float4(__uint_as_float(u.x << 16), __uint_as_float(u.x & 0xffff0000u), __uint_as_float(u.y << 16), __uint_as_float(u.y & 0xffff0000u));
    }
#pragma unroll
    for (int j = 0; j < 9; ++j) {
      const int i = i0 + 16 * j;
      if (j < 8 || i0 < 4) {
        const float4 v = kreg[j];
        Ks[i * 65 + sub * 4 + 0] = v.x; Ks[i * 65 + sub * 4 + 1] = v.y; Ks[i * 65 + sub * 4 + 2] = v.z; Ks[i * 65 + sub * 4 + 3] = v.w;
        if (i >= 4) ntst4(v, p.out + O_SCK + ((((size_t)l * 128 + bs) * 128 + (i - 4)) * 2 + kvh) * 64 + sub * 4);
      }
    }
    {
      const int row = tid >> 4, hq = row >> 2, t = row & 3;
      uint2 u = *(const uint2*)(z + (size_t)(mrow0 + t) * ZC + 1536 + (kvh * 4 + hq) * 64 + sub * 4);
      *(float4*)(Qs + row * 64 + sub * 4) = make_float4(__uint_as_float(u.x << 16), __uint_as_float(u.x & 0xffff0000u), __uint_as_float(u.y << 16), __uint_as_float(u.y & 0xffff0000u));
    }
  }
  half_sync(hb);
  for (int idx = tid; idx < 16 * 132; idx += 256) {
    const int row = idx / 132, i = idx - row * 132, t = row & 3;
    float s = 0.f;
#pragma unroll 16
    for (int d = 0; d < 64; ++d) s += Qs[row * 64 + d] * Ks[i * 65 + d];
    const bool ok = (t < i) && (i <= 128 + t);
    Ss[row * 132 + i] = ok ? s : -INFINITY;
  }
  half_sync(hb);
  {
    const int row = tid >> 4, c = tid & 15, hq = row >> 2;
    const float sink = p.sinks[l * 8 + kvh * 4 + hq];
    float m = -INFINITY;
    for (int i = c; i < 132; i += 16) m = fmaxf(m, Ss[row * 132 + i]);
    m = max16(m);
    m = fmaxf(m, sink);
    float sm = 0.f;
    for (int i = c; i < 132; i += 16) { float pv = __expf(Ss[row * 132 + i] - m); Ss[row * 132 + i] = pv; sm += pv; }
    sm = sum16(sm);
    if (c == 0) Rd[row] = 1.f / (sm + __expf(sink - m));
  }
  {
    const int sub = tid & 15, i0 = tid >> 4;
    const float* vbase = p.cache_v + ((((size_t)l * 128 + bs) * 128 + i0) * 2 + kvh) * 64 + sub * 4;
    float* obase = p.out + O_SCV + ((((size_t)l * 128 + bs) * 128 + i0) * 2 + kvh) * 64 + sub * 4;
#define VLD(j) const float4 vr##j = ntld4(vbase + (size_t)(16 * j) * 128);
    VLD(0) VLD(1) VLD(2) VLD(3) VLD(4) VLD(5) VLD(6) VLD(7)
#undef VLD
    const uint2 u8 = *(const uint2*)(z + (size_t)(mrow0 + (i0 & 3)) * ZC + 2176 + kvh * 64 + sub * 4);
    const float4 vr8 = make_float4(__uint_as_float(u8.x << 16), __uint_as_float(u8.x & 0xffff0000u), __uint_as_float(u8.y << 16), __uint_as_float(u8.y & 0xffff0000u));
#define VST(j) { *(float4*)(Ks + (i0 + 16 * j) * 64 + sub * 4) = vr##j; if (i0 + 16 * j >= 4) ntst4(vr##j, obase + ((ptrdiff_t)(16 * j) - 4) * 128); }
    VST(0) VST(1) VST(2) VST(3) VST(4) VST(5) VST(6) VST(7)
    if (i0 < 4) VST(8)
#undef VST
  }
  half_sync(hb);
  {
    const int row = tid >> 4, d4 = (tid & 15) * 4, hq = row >> 2, t = row & 3;
    float4 o = make_float4(0.f, 0.f, 0.f, 0.f);
    for (int i = 0; i < 132; ++i) {
      const float pv = Ss[row * 132 + i];
      const float4 v = *(const float4*)(Ks + i * 64 + d4);
      o.x += pv * v.x; o.y += pv * v.y; o.z += pv * v.z; o.w += pv * v.w;
    }
    const float rd = Rd[row];
    uint2 u; u.x = pack2(o.x * rd, o.y * rd); u.y = pack2(o.z * rd, o.w * rd);
    *(uint2*)(p.ocat + (size_t)(mrow0 + t) * 1024 + 512 + (kvh * 4 + hq) * 64 + d4) = u;
  }
}

DEVI void gla_gate_cumsum(const Params& p, int l, int h, int m0, float* bS, float* w2S, float* gaS, float* tot, HalfBar& hb) {
  const int tid = otid();
  for (int i = tid; i < 16 * 64; i += 256) w2S[i] = p.w_gk2[((size_t)l * 16 + (i >> 6)) * 256 + h * 64 + (i & 63)];
  if (tid < 64) w2S[1024 + tid] = p.b_gk2[l * 256 + h * 64 + tid];
  *(float4*)(gaS + tid * 4) = *(const float4*)(p.ga + (size_t)m0 * 16 + tid * 4);
  half_sync(hb);
  const int k = tid & 63, seg = tid >> 6;
  {
    float wk[16];
#pragma unroll
    for (int r = 0; r < 16; ++r) wk[r] = w2S[r * 64 + k];
    const float bias = w2S[1024 + k];
    float run = 0.f;
#pragma unroll 4
    for (int tt = 0; tt < 16; ++tt) {
      const int t = seg * 16 + tt;
      float x = bias;
#pragma unroll
      for (int r = 0; r < 16; ++r) x += gaS[t * 16 + r] * wk[r];
      run += logsig(x) * (1.f / 16.f);
      bS[t * 65 + k] = run;
    }
    tot[seg * 64 + k] = run;
  }
  half_sync(hb);
  {
    float off = 0.f;
    for (int sg = 0; sg < seg; ++sg) off += tot[sg * 64 + k];
#pragma unroll 4
    for (int tt = 0; tt < 16; ++tt) {
      const int t = seg * 16 + tt;
      const float v = bS[t * 65 + k] + off;
      bS[t * 65 + k] = v;
      p.bbuf[(size_t)(m0 + t) * 256 + h * 64 + k] = v;
    }
  }
  half_sync(hb);
}

DEVI void gla_chunk_item(const Params& p, int l, int it, unsigned char* smem, HalfBar& hb) {
  const int tid = otid(), lane = tid & 63, w = tid >> 6, fr = lane & 15, fq = lane >> 4;
  const int h = it & 3, n = (it >> 2) & 127, bb = it >> 9;
  const int m0 = bb * SEQ + n * 64;
  float* bS = (float*)smem;
  float* w2S = (float*)(smem + 16640);
  float* gaS = (float*)(smem + 16640 + 4352);
  float* tot = (float*)(smem + 16640 + 4352 + 4096);
  half_sync(hb);
  gla_gate_cumsum(p, l, h, m0, bS, w2S, gaS, tot, hb);
  const int k = 16 * w + fr;
  const float bl = bS[63 * 65 + k];
  bf16x8 af[2];
#pragma unroll
  for (int ks = 0; ks < 2; ++ks) {
    const uint4 kraw = *(const uint4*)(p.zT + (size_t)(h * 64 + k) * ZTP + m0 + ks * 32 + fq * 8);
    float f[8];
    unpack8(kraw, f);
    union { bf16x8 v; unsigned u[4]; } a;
#pragma unroll
    for (int e = 0; e < 4; ++e) {
      const int s0 = ks * 32 + fq * 8 + 2 * e;
      a.u[e] = pack2(f[2 * e] * __expf(bl - bS[s0 * 65 + k]), f[2 * e + 1] * __expf(bl - bS[(s0 + 1) * 65 + k]));
    }
    af[ks] = a.v;
  }
  float* Up = p.U + ((size_t)(bb * 128 + n) * 4 + h) * 8192;
#pragma unroll
  for (int vt = 0; vt < 8; ++vt) {
    const bfraw* vp = p.zT + (size_t)(256 + h * 128 + vt * 16 + fr) * ZTP + m0 + fq * 8;
    const bf16x8 v0 = *(const bf16x8*)(vp), v1 = *(const bf16x8*)(vp + 32);
    f32x4 acc = (f32x4){0.f, 0.f, 0.f, 0.f};
    acc = __builtin_amdgcn_mfma_f32_16x16x32_bf16(af[0], v0, acc, 0, 0, 0);
    acc = __builtin_amdgcn_mfma_f32_16x16x32_bf16(af[1], v1, acc, 0, 0, 0);
    *(f32x4*)(Up + (size_t)(vt * 16 + fr) * 64 + 16 * w + fq * 4) = acc;
  }
  if (tid < 64) p.dn[((size_t)(bb * 128 + n) * 4 + h) * 64 + tid] = __expf(bS[63 * 65 + tid]);
}

DEVI void gla_scan_item(const Params& p, int l, int it) {
  const int e = it * 256 + otid();
  const int bb = e >> 15, rem = e & 32767, h = rem >> 13, vk = rem & 8191, k = vk & 63, v = vk >> 6;
  float S = 0.f;
#pragma unroll 1
  for (int n0 = 0; n0 < 128; n0 += 16) {
    float u[16], d[16];
#pragma unroll
    for (int j = 0; j < 16; ++j) {
      u[j] = __builtin_nontemporal_load(p.U + ((size_t)(bb * 128 + n0 + j) * 4 + h) * 8192 + vk);
      d[j] = p.dn[((size_t)(bb * 128 + n0 + j) * 4 + h) * 64 + k];
    }
#pragma unroll
    for (int j = 0; j < 16; ++j) {
      p.Sp[((size_t)(bb * 128 + n0 + j) * 4 + h) * 8192 + vk] = f2bf(S);
      S = d[j] * S + u[j];
    }
  }
  p.out[O_PSG + (((size_t)l * 2 + bb) * 4 + h) * 8192 + k * 128 + v] = S;
}

DEVI void gla_out_wave(const Params& p, int l, int wi) {
  const int lane = lane_id(), fr = lane & 15, fq = lane >> 4;
  const int half = wi & 1, h = (wi >> 1) & 3, n = (wi >> 3) & 127, bb = wi >> 10;
  const int m0 = bb * SEQ + n * 64;
  const bfraw* z = p.zh;
  uint4 kraw[2][2][2]; float4 kb[2][2][2][2];
#pragma unroll
  for (int pr = 0; pr < 2; ++pr)
#pragma unroll
    for (int ab = 0; ab < 2; ++ab) {
      const int ms = m0 + 32 * pr + (fr >> 2) * 8 + ab * 4 + (fr & 3);
#pragma unroll
      for (int ks = 0; ks < 2; ++ks) {
        kraw[pr][ab][ks] = *(const uint4*)(z + (size_t)ms * ZC + 256 + h * 64 + ks * 32 + fq * 8);
        kb[pr][ab][ks][0] = *(const float4*)(p.bbuf + (size_t)ms * 256 + h * 64 + ks * 32 + fq * 8);
        kb[pr][ab][ks][1] = *(const float4*)(p.bbuf + (size_t)ms * 256 + h * 64 + ks * 32 + fq * 8 + 4);
      }
    }
  uint4 qraw[2][2]; float4 qb[2][2][2];
#pragma unroll
  for (int ti = 0; ti < 2; ++ti) {
    const int m = m0 + (half * 2 + ti) * 16 + fr;
#pragma unroll
    for (int ks = 0; ks < 2; ++ks) {
      qraw[ti][ks] = *(const uint4*)(z + (size_t)m * ZC + h * 64 + ks * 32 + fq * 8);
      qb[ti][ks][0] = *(const float4*)(p.bbuf + (size_t)m * 256 + h * 64 + ks * 32 + fq * 8);
      qb[ti][ks][1] = *(const float4*)(p.bbuf + (size_t)m * 256 + h * 64 + ks * 32 + fq * 8 + 4);
    }
  }
  asm volatile("" ::: "memory");
  bf16x8 kt[2][2][2], qt[2][2];
#pragma unroll
  for (int pr = 0; pr < 2; ++pr)
#pragma unroll
    for (int ab = 0; ab < 2; ++ab)
#pragma unroll
      for (int ks = 0; ks < 2; ++ks) {
        float f[8];
        unpack8(kraw[pr][ab][ks], f);
        const float4 b0 = kb[pr][ab][ks][0], b1 = kb[pr][ab][ks][1];
        union { bf16x8 v; unsigned u[4]; } kk;
        kk.u[0] = pack2(f[0] * __expf(-b0.x), f[1] * __expf(-b0.y)); kk.u[1] = pack2(f[2] * __expf(-b0.z), f[3] * __expf(-b0.w));
        kk.u[2] = pack2(f[4] * __expf(-b1.x), f[5] * __expf(-b1.y)); kk.u[3] = pack2(f[6] * __expf(-b1.z), f[7] * __expf(-b1.w));
        kt[pr][ab][ks] = kk.v;
      }
#pragma unroll
  for (int ti = 0; ti < 2; ++ti)
#pragma unroll
    for (int ks = 0; ks < 2; ++ks) {
      float f[8];
      unpack8(qraw[ti][ks], f);
      const float4 b0 = qb[ti][ks][0], b1 = qb[ti][ks][1];
      union { bf16x8 v; unsigned u[4]; } a;
      a.u[0] = pack2(f[0] * __expf(b0.x), f[1] * __expf(b0.y)); a.u[1] = pack2(f[2] * __expf(b0.z), f[3] * __expf(b0.w));
      a.u[2] = pack2(f[4] * __expf(b1.x), f[5] * __expf(b1.y)); a.u[3] = pack2(f[6] * __expf(b1.z), f[7] * __expf(b1.w));
      qt[ti][ks] = a.v;
    }
  asm volatile("" ::: "memory");
  f32x4 o[2][8];
  {
    bf16x8 sf[8][2];
    const bfraw* sp = p.Sp + ((size_t)(bb * 128 + n) * 4 + h) * 8192 + (size_t)fr * 64 + fq * 8;
#pragma unroll
    for (int vt = 0; vt < 8; ++vt) { sf[vt][0] = *(const bf16x8*)(sp + vt * 1024); sf[vt][1] = *(const bf16x8*)(sp + vt * 1024 + 32); }
#pragma unroll
    for (int ti = 0; ti < 2; ++ti)
#pragma unroll
      for (int vt = 0; vt < 8; ++vt) {
        f32x4 a = (f32x4){0.f, 0.f, 0.f, 0.f};
        a = __builtin_amdgcn_mfma_f32_16x16x32_bf16(sf[vt][0], qt[ti][0], a, 0, 0, 0);
        a = __builtin_amdgcn_mfma_f32_16x16x32_bf16(sf[vt][1], qt[ti][1], a, 0, 0, 0);
        o[ti][vt] = a;
      }
  }
  asm volatile("" ::: "memory");
  bf16x8 vfr[2][8];
#pragma unroll
  for (int pr = 0; pr < 2; ++pr)
#pragma unroll
    for (int vt = 0; vt < 8; ++vt)
      vfr[pr][vt] = *(const bf16x8*)(p.zT + (size_t)(256 + h * 128 + vt * 16 + fr) * ZTP + m0 + pr * 32 + fq * 8);
#pragma unroll
  for (int ti = 0; ti < 2; ++ti) {
    const int t = (half * 2 + ti) * 16 + fr;
#pragma unroll
    for (int pr = 0; pr < 2; ++pr) {
      f32x4 at[2];
#pragma unroll
      for (int ab = 0; ab < 2; ++ab) {
        f32x4 a = (f32x4){0.f, 0.f, 0.f, 0.f};
        a = __builtin_amdgcn_mfma_f32_16x16x32_bf16(kt[pr][ab][0], qt[ti][0], a, 0, 0, 0);
        a = __builtin_amdgcn_mfma_f32_16x16x32_bf16(kt[pr][ab][1], qt[ti][1], a, 0, 0, 0);
#pragma unroll
        for (int j = 0; j < 4; ++j) {
          const int sidx = 32 * pr + fq * 8 + ab * 4 + j;
          a[j] = (sidx <= t) ? a[j] : 0.f;
        }
        at[ab] = a;
      }
      union { bf16x8 v; unsigned u[4]; } pb;
      pb.u[0] = pack2(at[0][0], at[0][1]); pb.u[1] = pack2(at[0][2], at[0][3]);
      pb.u[2] = pack2(at[1][0], at[1][1]); pb.u[3] = pack2(at[1][2], at[1][3]);
#pragma unroll
      for (int vt = 0; vt < 8; ++vt) o[ti][vt] = __builtin_amdgcn_mfma_f32_16x16x32_bf16(vfr[pr][vt], pb.v, o[ti][vt], 0, 0, 0);
    }
  }
  asm volatile("" ::: "memory");
#pragma unroll
  for (int ti = 0; ti < 2; ++ti) {
    const int m = m0 + (half * 2 + ti) * 16 + fr;
    uint2 gu[8];
#pragma unroll
    for (int vt = 0; vt < 8; ++vt) gu[vt] = *(const uint2*)(z + (size_t)m * ZC + 1024 + h * 128 + vt * 16 + fq * 4);
    float ss = 0.f;
#pragma unroll
    for (int vt = 0; vt < 8; ++vt) ss += o[ti][vt][0] * o[ti][vt][0] + o[ti][vt][1] * o[ti][vt][1] + o[ti][vt][2] * o[ti][vt][2] + o[ti][vt][3] * o[ti][vt][3];
    ss += shx(ss, 16); ss += shx(ss, 32);
    const float rs = rsqrtf(ss * (1.f / 128.f) + EPS);
#pragma unroll
    for (int vt = 0; vt < 8; ++vt) {
      const int v = vt * 16 + fq * 4;
      const float4 gn = *(const float4*)(p.gla_norm + l * 128 + v);
      const float g0 = __uint_as_float(gu[vt].x << 16), g1 = __uint_as_float(gu[vt].x & 0xffff0000u);
      const float g2 = __uint_as_float(gu[vt].y << 16), g3 = __uint_as_float(gu[vt].y & 0xffff0000u);
      uint2 ou;
      ou.x = pack2(o[ti][vt][0] * rs * gn.x * silu_f(g0), o[ti][vt][1] * rs * gn.y * silu_f(g1));
      ou.y = pack2(o[ti][vt][2] * rs * gn.z * silu_f(g2), o[ti][vt][3] * rs * gn.w * silu_f(g3));
      *(uint2*)(p.ocat + (size_t)m * 1024 + h * 128 + v) = ou;
    }
  }
}

DEVI void gla_sample_item(const Params& p, int l, int it, unsigned char* smem, HalfBar& hb) {
  const int tid = otid(), lane = tid & 63, w = tid >> 6;
  const int h = it & 3, bs = it >> 2;
  const bfraw* z = p.zh;
  float* eS = (float*)smem;
  float* qS = eS + 256;
  float* kS = qS + 256;
  float* vS = kS + 256;
  float* oS = vS + 512;
  const int mrow0 = MP + bs * 4;
  float S[32];
  {
    const float* sp = p.state_gla + ((((size_t)l * 128 + bs) * 4 + h) * 64 + (tid >> 7) * 32) * 128 + (tid & 127);
#pragma unroll
    for (int i = 0; i < 32; ++i) S[i] = __builtin_nontemporal_load(sp + (size_t)i * 128);
  }
  const float g0r = bf2f(z[(size_t)(mrow0 + w) * ZC + 1024 + h * 128 + lane]), g1r = bf2f(z[(size_t)(mrow0 + w) * ZC + 1024 + h * 128 + 64 + lane]);
  half_sync(hb);
  {
    const int t = w, k = lane;
    const float* gp = p.ga + (size_t)(mrow0 + t) * 16;
    float x = p.b_gk2[l * 256 + h * 64 + k];
#pragma unroll
    for (int r = 0; r < 16; ++r) x += gp[r] * p.w_gk2[((size_t)l * 16 + r) * 256 + h * 64 + k];
    eS[t * 64 + k] = __expf(logsig(x) * (1.f / 16.f));
    qS[t * 64 + k] = bf2f(z[(size_t)(mrow0 + t) * ZC + h * 64 + k]);
    kS[t * 64 + k] = bf2f(z[(size_t)(mrow0 + t) * ZC + 256 + h * 64 + k]);
    vS[t * 128 + k] = bf2f(z[(size_t)(mrow0 + t) * ZC + 512 + h * 128 + k]);
    vS[t * 128 + 64 + k] = bf2f(z[(size_t)(mrow0 + t) * ZC + 512 + h * 128 + 64 + k]);
  }
  half_sync(hb);
  {
    const int v = tid & 127, half = tid >> 7;
#pragma unroll
    for (int t = 0; t < 4; ++t) {
      const float vv = vS[t * 128 + v];
      float op = 0.f;
#pragma unroll
      for (int i = 0; i < 32; ++i) {
        const int k = half * 32 + i;
        S[i] = eS[t * 64 + k] * S[i] + kS[t * 64 + k] * vv;
        op += qS[t * 64 + k] * S[i];
      }
      oS[(t * 2 + half) * 128 + v] = op;
    }
    float* so = p.out + O_SSG + ((((size_t)l * 128 + bs) * 4 + h) * 64 + half * 32) * 128 + v;
#pragma unroll
    for (int i = 0; i < 32; ++i) __builtin_nontemporal_store(S[i], so + (size_t)i * 128);
  }
  half_sync(hb);
  {
    const int t = w;
    float o0 = oS[(t * 2) * 128 + lane] + oS[(t * 2 + 1) * 128 + lane];
    float o1 = oS[(t * 2) * 128 + 64 + lane] + oS[(t * 2 + 1) * 128 + 64 + lane];
    float ss = sum64(o0 * o0 + o1 * o1);
    const float rs = rsqrtf(ss * (1.f / 128.f) + EPS);
    const float g0 = g0r, g1 = g1r;
    bfraw* op = p.ocat + (size_t)(mrow0 + t) * 1024 + h * 128;
    op[lane] = f2bf(o0 * rs * p.gla_norm[l * 128 + lane] * silu_f(g0));
    op[64 + lane] = f2bf(o1 * rs * p.gla_norm[l * 128 + 64 + lane] * silu_f(g1));
  }
}

DEVI void final_item(const Params& p, int it) {
  const int tid = otid(), lane = tid & 63, w = tid >> 6;
  const int m = it * 4 + w;
  const float4* q = (const float4*)(p.ssq + (size_t)m * 16);
  float4 a = q[0], b = q[1], c = q[2], d = q[3];
  float s = ((a.x + a.y) + (a.z + a.w)) + ((b.x + b.y) + (b.z + b.w)) + ((c.x + c.y) + (c.z + c.w)) + ((d.x + d.y) + (d.z + d.w));
  const float rs = rsqrtf(s * (1.f / 1024.f) + EPS);
#pragma unroll
  for (int i = 0; i < 4; ++i) {
    const int col = lane * 4 + i * 256;
    const uint2 xr = *(const uint2*)(p.xb + (size_t)m * 1024 + col);
    float4 v = make_float4(__uint_as_float(xr.x << 16), __uint_as_float(xr.x & 0xffff0000u), __uint_as_float(xr.y << 16), __uint_as_float(xr.y & 0xffff0000u));
    const float4 g = *(const float4*)(p.norm_final + col);
    v.x *= rs * g.x; v.y *= rs * g.y; v.z *= rs * g.z; v.w *= rs * g.w;
    ntst4(v, p.out + (size_t)m * 1024 + col);
  }
}

DEVI void run_phase(const Params& p, int ph, unsigned char* smem_all, int rep) {
  const int l = (ph - 1) / 9, s = (ph - 1) % 9;
  if (ph > 0 && ph < NPHASE - 1 && (s == 0 || s == 4 || s == 6 || s == 7)) {
    unsigned* qc = (l < 3) ? (p.qctr + (l * 2 + (s == 6)) * 16) : nullptr;
    if (s == 0) gemm_phase<EPI_IN>(p, l, p.xb, p.WinT + (size_t)l * NINP * 1024, 1024, 10, smem_all, qc, (l + 1) * 3008, (l + 1) * 3008 + 1760);
    else if (s == 6) {
      gemm_phase<EPI_GU>(p, l, p.xb, p.WguT + (size_t)l * 5632 * 1024, 1024, 22, smem_all, qc, (l + 1) * 3008 + 1760, (l + 2) * 3008);
      {
        const int wg = blockIdx.x * 8 + __builtin_amdgcn_readfirstlane(otid512() >> 6), nw = gridDim.x * 8;
        const uint4* wp = (const uint4*)(p.WdT + (size_t)l * 1024 * 2816);
        for (size_t i = (size_t)wg * 64 + lane_id(); i < (size_t)1024 * 2816 * 2 / 16; i += (size_t)nw * 64) {
          uint4 w0 = wp[i];
          asm volatile("" :: "v"(w0.x), "v"(w0.y), "v"(w0.z), "v"(w0.w));
        }
      }
    }
    else {
      const bool dn = (s == 7);
      gemm_res_phase(p, l, dn ? p.zh : p.ocat, dn ? (p.WdT + (size_t)l * 1024 * 2816) : (p.WoT + (size_t)l * 1024 * 1024),
                     dn ? DFF : 1024, dn ? 11 : 4, smem_all);
    }
    return;
  }
  const int vh = (otid512() >> 8) & 1;
  const int vb = blockIdx.x * 2 + vh, nvb = gridDim.x * 2;
  unsigned char* smem = smem_all + vh * 73728;
  if (ph == 0) { phase_prologue(p, smem, vb, nvb); return; }
  if (ph == NPHASE - 1) {
    for (int it = vb; it < M_TOK / 4; it += nvb) final_item(p, it);
    return;
  }
  switch (s) {
    case 1: {
      HalfBar hb; hb.cnt = (volatile LAS unsigned*)(smem_all + 2 * 73728 - 64 + vh * 32); hb.target = *hb.cnt;
      __syncthreads();
      if (vh == 0) {
        for (int it = blockIdx.x; it < 768; it += gridDim.x) {
          if (it < 512) gla_sample_item(p, l, it, smem, hb);
          else swa_sample_item(p, l, it - 512, smem, hb);
        }
      } else {
        for (int it = blockIdx.x; it < 1024; it += gridDim.x) gla_chunk_item(p, l, it, smem, hb);
      }
      prompt_cache_copy(p, l, vb, nvb);
      {
        const int wg = blockIdx.x * 8 + __builtin_amdgcn_readfirstlane(otid512() >> 6), nw = gridDim.x * 8;
        for (int wi = wg; wi < 2048; wi += nw) swa_prompt_wave(p, l, wi);
      }
    } break;
    case 2:
      for (int it = vb; it < 256; it += nvb) gla_scan_item(p, l, it);
      break;
    case 3: {
      const int wg = blockIdx.x * 8 + __builtin_amdgcn_readfirstlane(otid512() >> 6), nw = gridDim.x * 8;
      for (int wi = wg; wi < 2048; wi += nw) gla_out_wave(p, l, wi);
      {
        const uint4* wp = (const uint4*)(p.WoT + (size_t)l * 1024 * 1024) + (size_t)wg * 64 + lane_id();
        uint4 w0 = *wp;
        asm volatile("" :: "v"(w0.x), "v"(w0.y), "v"(w0.z), "v"(w0.w));
      }
    } break;
    case 5: {
      const int wg = blockIdx.x * 8 + __builtin_amdgcn_readfirstlane(otid512() >> 6), nw = gridDim.x * 8;
      for (int wi = wg; wi < 2048; wi += nw) fin_wave<4>(p, wi);
    } break;
    case 8: {
      const int wg = blockIdx.x * 8 + __builtin_amdgcn_readfirstlane(otid512() >> 6), nw = gridDim.x * 8;
      for (int wi = wg; wi < 2048; wi += nw) fin_wave<11>(p, wi);
    } break;
  }
}

__global__ void __launch_bounds__(512, 2) mega_kernel(Params p, int ph_lo, int ph_hi) {
  __shared__ __attribute__((aligned(16))) unsigned char smem[2 * 73728];
  uint4* xb_words = (uint4*)(smem + 2 * 73728 - 16);
  if (otid512() == 0) { *xb_words = make_uint4(0u, 0u, 0u, 0u); *(uint4*)(smem + 2 * 73728 - 64) = make_uint4(0u, 0u, 0u, 0u); *(uint4*)(smem + 2 * 73728 - 32) = make_uint4(0u, 0u, 0u, 0u); }
  __syncthreads();
  XcdBarrier xb = xcd_barrier_post(p.bar, (volatile LAS unsigned*)xb_words);
  if (ph_hi < 0) cg::this_grid().sync();
  for (int ph = ph_lo; ph < ph_hi; ++ph) {
    int reps = 1;
#ifdef DUP_MASK
    if (ph > 0 && ph < NPHASE - 1 && ((DUP_MASK >> ((ph - 1) % 9)) & 1)) reps = 2;
#endif
#ifdef DUP_PRO
    if (ph == 0) reps = 2;
#endif
    for (int r = 0; r < reps; ++r) {
      run_phase(p, ph, smem, r);
      if (ph + 1 < ph_hi || r + 1 < reps) xcd_barrier(xb);
    }
#ifdef DUP_SYNC
    if (ph > 0 && ph < NPHASE - 1) xcd_barrier(xb);
#endif
  }
}

extern "C" void kernel_launch(void* const* d_in, const int* in_sizes, int n_in, void* d_out, int out_size, void* d_ws,
                              size_t ws_size, hipStream_t stream) {
  static int grid_blocks = 0;
  if (!grid_blocks) {
    int dev = 0, cus = 0, per_cu = 0;
    hipGetDevice(&dev);
    hipDeviceGetAttribute(&cus, hipDeviceAttributeMultiprocessorCount, dev);
    hipOccupancyMaxActiveBlocksPerMultiprocessor(&per_cu, mega_kernel, 512, 0);
    if (per_cu < 1) per_cu = 1;
    if (per_cu > 1) per_cu = 1;
    grid_blocks = cus * per_cu;
  }
  Params p{};
  p.x_prompt = (const float*)d_in[0]; p.x_sample = (const float*)d_in[1]; p.state_gla = (const float*)d_in[2];
  p.cache_k = (const float*)d_in[3]; p.cache_v = (const float*)d_in[4]; p.norm_attn = (const float*)d_in[5];
  p.w_in = (const float*)d_in[6]; p.w_gk2 = (const float*)d_in[7]; p.b_gk2 = (const float*)d_in[8];
  p.gla_norm = (const float*)d_in[9]; p.sinks = (const float*)d_in[10]; p.w_o = (const float*)d_in[11];
  p.norm_ffn = (const float*)d_in[12]; p.w_gate = (const float*)d_in[13]; p.w_up = (const float*)d_in[14];
  p.w_down = (const float*)d_in[15]; p.norm_final = (const float*)d_in[16];
  p.out = (float*)d_out;
  unsigned char* ws = (unsigned char*)d_ws;
  size_t off = 0;
  auto take = [&](size_t bytes) { unsigned char* r = ws + off; off += (bytes + 255) & ~(size_t)255; return r; };
  p.WinT = (bfraw*)take((size_t)4 * NINP * 1024 * 2);
  p.WoT = (bfraw*)take((size_t)4 * 1024 * 1024 * 2);
  p.WguT = (bfraw*)take((size_t)4 * 5632 * 1024 * 2);
  p.WdT = (bfraw*)take((size_t)4 * 1024 * 2816 * 2);
  p.xb = (bfraw*)take((size_t)M_TOK * 1024 * 2);
  p.zh = (bfraw*)take((size_t)M_TOK * DFF * 2);
  p.ocat = (bfraw*)take((size_t)M_TOK * 1024 * 2);
  p.zT = (bfraw*)take((size_t)896 * ZTP * 2);
  p.ssq = (float*)take((size_t)M_TOK * 16 * 4);
  p.ga = (float*)take((size_t)M_TOK * 16 * 4);
  p.U = (float*)take((size_t)2 * 128 * 4 * 8192 * 4);
  p.dn = (float*)take((size_t)2 * 128 * 4 * 64 * 4);
  p.Sp = (bfraw*)take((size_t)2 * 128 * 4 * 8192 * 2);
  p.bbuf = (float*)take((size_t)MP * 256 * 4);
  p.rope = (float2*)take((size_t)8196 * 32 * 8);
  p.bar = (unsigned*)take((size_t)(XCD_BAR_WORDS + 256) * 4);
  p.qctr = p.bar + XCD_BAR_WORDS;
  if (off > ws_size) { fprintf(stderr, "workspace too small: need %zu have %zu\n", off, ws_size); return; }
  (void)hipMemsetAsync(p.bar, 0, (size_t)(XCD_BAR_WORDS + 256) * 4, stream);
#if MULTI_LAUNCH
  for (int ph = 0; ph < NPHASE; ++ph) {
    hipLaunchKernelGGL(mega_kernel, dim3(grid_blocks), dim3(512), 0, stream, p, ph, ph + 1);
  }
#else
  int lo = 0, hi = NPHASE;
  void* args[] = {&p, &lo, &hi};
  hipError_t e = hipLaunchCooperativeKernel((void*)mega_kernel, dim3(grid_blocks), dim3(512), args, 0, stream);
  if (e != hipSuccess) fprintf(stderr, "cooperative launch failed: %s (grid %d)\n", hipGetErrorString(e), grid_blocks);
#endif
}
```

```cpp
#include <hip/hip_runtime.h>
#include <hip/hip_bf16.h>
#include <hip/hip_cooperative_groups.h>
#include <cstdio>
namespace cg = cooperative_groups;

#ifndef MULTI_LAUNCH
#define MULTI_LAUNCH 0
#endif

typedef unsigned short bfraw;
using bf16x8 = __attribute__((ext_vector_type(8))) short;
using f32x4  = __attribute__((ext_vector_type(4))) float;
#define DEVI __device__ __forceinline__
#define LAS __attribute__((address_space(3)))

constexpr int M_TOK = 16896, MP = 16384, DM = 1024, ZC = 2304, NINP = 2560, DFF = 2816, SEQ = 8192;
constexpr int NPHASE = 38;
constexpr int ZTP = M_TOK + 64;
constexpr float EPS = 1e-6f;

constexpr size_t O_YP = 0, O_PSG = 17301504, O_PCK = 17563648, O_PCV = 17694720,
                 O_SSG = 17825792, O_SCK = 34603008, O_SCV = 42991616;

struct Params {
  const float *x_prompt, *x_sample, *state_gla, *cache_k, *cache_v, *norm_attn, *w_in, *w_gk2, *b_gk2,
              *gla_norm, *sinks, *w_o, *norm_ffn, *w_gate, *w_up, *w_down, *norm_final;
  float* out;
  bfraw *WinT, *WoT, *WguT, *WdT, *xb, *zh, *ocat, *zT;
  float *ssq, *ga, *U, *dn, *bbuf;
  bfraw* Sp;
  float2* rope;
  unsigned* bar;
  unsigned* qctr;
};

DEVI int lane_id() { int l; asm volatile("v_mbcnt_lo_u32_b32 %0, -1, 0\n\tv_mbcnt_hi_u32_b32 %0, -1, %0" : "=v"(l)); return l; }
DEVI int otid512() { const int w = __builtin_amdgcn_readfirstlane((int)(threadIdx.x >> 6)); return w * 64 + lane_id(); }
DEVI int otid() { return otid512() & 255; }
struct HalfBar { volatile LAS unsigned* cnt; unsigned target; };
DEVI void half_sync(HalfBar& hb) {
  asm volatile("s_waitcnt lgkmcnt(0)" ::: "memory");
  hb.target += 4u;
  if (lane_id() == 0) __hip_atomic_fetch_add((LAS unsigned*)hb.cnt, 1u, __ATOMIC_RELAXED, __HIP_MEMORY_SCOPE_WORKGROUP);
  while (*hb.cnt < hb.target) __builtin_amdgcn_s_sleep(0);
  asm volatile("s_waitcnt lgkmcnt(0)" ::: "memory");
}
DEVI float4 ntld4(const float* p) { const f32x4 v = __builtin_nontemporal_load((const f32x4*)p); return make_float4(v[0], v[1], v[2], v[3]); }
DEVI void ntst4(float4 v, float* p) { f32x4 w = {v.x, v.y, v.z, v.w}; __builtin_nontemporal_store(w, (f32x4*)p); }
DEVI float shx(float v, int mask) { const int l = lane_id(); return __int_as_float(__builtin_amdgcn_ds_bpermute((l ^ mask) << 2, __float_as_int(v))); }
DEVI bfraw f2bf(float f) { unsigned u = __float_as_uint(f); u += 0x7fffu + ((u >> 16) & 1u); return (bfraw)(u >> 16); }
DEVI float bf2f(bfraw h) { return __uint_as_float(((unsigned)h) << 16); }
typedef __bf16 bf16v2_t __attribute__((ext_vector_type(2)));
typedef float f32v2_t __attribute__((ext_vector_type(2)));
DEVI unsigned pack2(float a, float b) { f32v2_t v = {a, b}; bf16v2_t r = __builtin_convertvector(v, bf16v2_t); return __builtin_bit_cast(unsigned, r); }
DEVI float sum16(float v) { v += shx(v, 1); v += shx(v, 2); v += shx(v, 4); v += shx(v, 8); return v; }
DEVI float max16(float v) { v = fmaxf(v, shx(v, 1)); v = fmaxf(v, shx(v, 2)); v = fmaxf(v, shx(v, 4)); v = fmaxf(v, shx(v, 8)); return v; }
DEVI float sum64(float v) { v = sum16(v); v += shx(v, 16); v += shx(v, 32); return v; }
DEVI float silu_f(float x) { return __fdividef(x, 1.f + __expf(-x)); }
DEVI float logsig(float x) { return fminf(x, 0.f) - __logf(1.f + __expf(-fabsf(x))); }
DEVI void unpack8(uint4 u, float* f) {
  f[0] = __uint_as_float(u.x << 16); f[1] = __uint_as_float(u.x & 0xffff0000u);
  f[2] = __uint_as_float(u.y << 16); f[3] = __uint_as_float(u.y & 0xffff0000u);
  f[4] = __uint_as_float(u.z << 16); f[5] = __uint_as_float(u.z & 0xffff0000u);
  f[6] = __uint_as_float(u.w << 16); f[7] = __uint_as_float(u.w & 0xffff0000u);
}


#define XB_TMO      128
#define XB_XCNT(j)  (256  + 64 * (j))
#define XB_XSUB(j)  (1280 + 64 * (j))
#define XB_XGEN(j)  (2304 + 64 * (j))
#define XB_TOP      3328
#define XB_TOPGEN   3392
#define XCD_BAR_WORDS 3456
#define XB_SPIN_CAP (1u << 22)
DEVI unsigned xb_ld(unsigned* p)              { return __hip_atomic_load(p, __ATOMIC_RELAXED, __HIP_MEMORY_SCOPE_AGENT); }
DEVI unsigned xb_add(unsigned* p, unsigned v) { return __hip_atomic_fetch_add(p, v, __ATOMIC_RELAXED, __HIP_MEMORY_SCOPE_AGENT); }
DEVI unsigned xb_xcc_id() { return (unsigned)__builtin_amdgcn_s_getreg((3 << 11) | 20) & 0xFu; }
#define XB_SPIN(cond, bar) do { unsigned _sp = 0; while (cond) { __builtin_amdgcn_s_sleep(1); \
    if ((++_sp & 255u) == 0u) { if (xb_ld(&(bar)[XB_TMO])) break; if (_sp > XB_SPIN_CAP) { atomicAdd(&(bar)[XB_TMO], 1u); break; } } } } while (0)
struct XcdBarrier { unsigned* bar; unsigned x; volatile LAS unsigned* st; };
DEVI XcdBarrier xcd_barrier_post(unsigned* bar, volatile LAS unsigned* st) {
  XcdBarrier b; b.bar = bar; b.x = xb_xcc_id(); b.st = st;
  if (otid512() == 0) (void)xb_add(&bar[XB_XCNT(b.x)], 1u);
  return b;
}
DEVI void xcd_barrier_complete(unsigned* bar, unsigned x, unsigned& nloc, unsigned& nx) {
  const unsigned G = gridDim.x * gridDim.y * gridDim.z;
  unsigned sum, cnt, mine, sp = 0u;
  for (;;) {
    sum = 0u; cnt = 0u; mine = 0u;
#pragma unroll
    for (unsigned j = 0; j < 16; ++j) { const unsigned c = xb_ld(&bar[XB_XCNT(j)]); sum += c; cnt += (c > 0u) ? 1u : 0u; mine = (j == x) ? c : mine; }
    if (sum == G) break;
    __builtin_amdgcn_s_sleep(1);
    if ((++sp & 255u) == 0u) { if (xb_ld(&bar[XB_TMO])) break; if (sp > XB_SPIN_CAP) { atomicAdd(&bar[XB_TMO], 1u); break; } }
  }
  nloc = mine > 0u ? mine : 1u; nx = cnt > 0u ? cnt : 1u;
}
DEVI void xcd_barrier(const XcdBarrier& b) {
  asm volatile("s_waitcnt vmcnt(0)" ::: "memory");
  __syncthreads();
  if (otid512() == 0) {
    unsigned* bar = b.bar;
    __builtin_amdgcn_s_waitcnt(0);
    unsigned nloc = b.st[0], nx = b.st[1];
    if (nloc == 0u) { xcd_barrier_complete(bar, b.x, nloc, nx); b.st[0] = nloc; b.st[1] = nx; }
    const unsigned old = xb_add(&bar[XB_XSUB(b.x)], 1u);
    const unsigned gen = old / nloc;
    if (old + 1u == (gen + 1u) * nloc) {
      __builtin_amdgcn_fence(__ATOMIC_RELEASE, "agent");
      asm volatile("s_waitcnt vmcnt(0)" ::: "memory");
      const unsigned og = xb_add(&bar[XB_TOP], 1u);
      const unsigned tg = og / nx;
      if (og + 1u == (tg + 1u) * nx) xb_add(&bar[XB_TOPGEN], 1u);
      else XB_SPIN(xb_ld(&bar[XB_TOPGEN]) == tg, bar);
      __builtin_amdgcn_fence(__ATOMIC_ACQUIRE, "agent");
      xb_add(&bar[XB_XGEN(b.x)], 1u);
      asm volatile("s_waitcnt vmcnt(0)" ::: "memory");
    } else {
      XB_SPIN(xb_ld(&bar[XB_XGEN(b.x)]) == gen, bar);
      __builtin_amdgcn_fence(__ATOMIC_ACQUIRE, "agent");
      asm volatile("s_waitcnt vmcnt(0)" ::: "memory");
    }
  }
  __syncthreads();
}

DEVI float4 wsrc4(const Params& p, int type, int l, int k, int r) {
  float4 v; float sc = 1.f;
  if (type == 0) {
    const int q = r & 63;
    const int n = (r & ~63) + ((q >> 5) << 4) + (q & 15) + (((q >> 4) & 1) << 5);
    int col;
    if (n < 1024) col = n; else if (n < 2304) col = n + 16; else if (n < 2320) col = n - 1280; else return make_float4(0.f, 0.f, 0.f, 0.f);
    sc = p.norm_attn[l * 1024 + k];
    if (n < 256 || (n >= 1536 && n < 2048)) sc *= 0.125f;
    v = ntld4(p.w_in + ((size_t)l * 1024 + k) * 2320 + col);
  } else if (type == 1) {
    v = ntld4(p.w_o + ((size_t)l * 1024 + k) * 1024 + r);
  } else if (type == 2) {
    const int G = r >> 5, t = r & 31;
    const float* s = (t < 16) ? p.w_gate : p.w_up;
    sc = p.norm_ffn[l * 1024 + k];
    v = ntld4(s + ((size_t)l * 1024 + k) * 2816 + G * 16 + (t & 15));
  } else {
    v = ntld4(p.w_down + ((size_t)l * 2816 + k) * 1024 + r);
  }
  v.x *= sc; v.y *= sc; v.z *= sc; v.w *= sc;
  return v;
}

DEVI void transpose_item(const Params& p, int it, unsigned char* smem) {
  float* t = (float*)smem;
  const int tid = otid();
  int l = it / 3008, r = it % 3008;
  int type, ntile, ktile, K; bfraw* dst;
  if (r < 640) { type = 0; ntile = r / 16; ktile = r % 16; K = 1024; dst = p.WinT + (size_t)l * NINP * 1024; }
  else if (r < 896) { r -= 640; type = 1; ntile = r / 16; ktile = r % 16; K = 1024; dst = p.WoT + (size_t)l * 1024 * 1024; }
  else if (r < 2304) { r -= 896; type = 2; ntile = r / 16; ktile = r % 16; K = 1024; dst = p.WguT + (size_t)l * 5632 * 1024; }
  else { r -= 2304; type = 3; ntile = r / 44; ktile = r % 44; K = 2816; dst = p.WdT + (size_t)l * 1024 * 2816; }
  const int n0 = ntile * 64, k0 = ktile * 64;
  __syncthreads();
  {
    const int nq = (tid & 15) * 4, kb = tid >> 4;
    float4 v[4];
#pragma unroll
    for (int i = 0; i < 4; ++i) v[i] = wsrc4(p, type, l, k0 + kb + 16 * i, n0 + nq);
#pragma unroll
    for (int i = 0; i < 4; ++i) {
      float* tp = t + (kb + 16 * i) * 65 + nq;
      tp[0] = v[i].x; tp[1] = v[i].y; tp[2] = v[i].z; tp[3] = v[i].w;
    }
  }
  __syncthreads();
  {
    const int kc = tid & 7;
#pragma unroll
    for (int i = 0; i < 2; ++i) {
      int nn = (tid >> 3) + 32 * i;
      float v[8];
#pragma unroll
      for (int e = 0; e < 8; ++e) v[e] = t[(kc * 8 + e) * 65 + nn];
      uint4 o; o.x = pack2(v[0], v[1]); o.y = pack2(v[2], v[3]); o.z = pack2(v[4], v[5]); o.w = pack2(v[6], v[7]);
      { typedef unsigned u32x4_t __attribute__((ext_vector_type(4))); u32x4_t ov = {o.x, o.y, o.z, o.w}; __builtin_nontemporal_store(ov, (u32x4_t*)(dst + (size_t)(n0 + nn) * K + k0 + kc * 8)); }
    }
  }
}

DEVI void xconv_item(const Params& p, int it) {
  const int tid = otid(), lane = tid & 63, w = tid >> 6;
#pragma unroll 1
  for (int ps = 0; ps < 4; ++ps) {
    int m = it * 16 + ps * 4 + w;
    const float* src = (m < MP) ? (p.x_prompt + (size_t)m * 1024) : (p.x_sample + (size_t)(m - MP) * 1024);
    float ss = 0.f;
#pragma unroll
    for (int i = 0; i < 4; ++i) {
      int c = lane * 4 + i * 256;
      float4 v = ntld4(src + c);
      uint2 o; o.x = pack2(v.x, v.y); o.y = pack2(v.z, v.w);
      *(uint2*)(p.xb + (size_t)m * 1024 + c) = o;
      ss += v.x * v.x + v.y * v.y + v.z * v.z + v.w * v.w;
    }
    ss = sum64(ss);
    if (lane < 16) p.ssq[(size_t)m * 16 + lane] = (lane == 0) ? ss : 0.f;
  }
}

DEVI void rope_item(const Params& p, int it) {
  int idx = it * 256 + otid();
  if (idx < 8196 * 32) {
    int pos = idx >> 5, i = idx & 31;
    float inv = exp2f(-(float)i * 0.41524101186092029f);
    float ang = (float)pos * inv;
    double rev = (double)ang * 0.15915494309189535;
    rev -= rint(rev);
    float rf = (float)(rev * 6.283185307179586);
    p.rope[idx] = make_float2(__cosf(rf), __sinf(rf));
  }
}

DEVI void phase_prologue(const Params& p, unsigned char* smem, int vb, int nvb) {
  const int nT = 3008, nX = M_TOK / 16, nR = 1026;
  const int total = nT + nX + nR;
  for (int it = vb; it < total; it += nvb) {
    if (it < nT) transpose_item(p, it, smem);
    else if (it < nT + nX) xconv_item(p, it - nT);
    else rope_item(p, it - nT - nX);
  }
}

enum { EPI_IN = 0, EPI_RES = 1, EPI_GU = 2, EPI_PART = 3 };
constexpr int GBK = 64, GHALF = 128, GHT = GHALF * GBK;

DEVI int lds_byte(int r, int c) {
  int st = (r >> 4) * 2 + (c >> 5), rr = r & 15, cc = c & 31, ob = rr * 64 + cc * 2;
  return st * 1024 + (ob ^ (((ob >> 9) & 1) << 5));
}
DEVI void stage_rc(int b, int& R, int& C) {
  int st = b / 1024, sb = b % 1024, swz = sb ^ (((sb >> 9) & 1) << 5);
  R = (st >> 1) * 16 + swz / 64; C = (st & 1) * 32 + (swz % 64) / 2;
}

template <int EPI>
DEVI void gemm_unit(const Params& p, int l, const bfraw* A, const bfraw* Bt, const int LD, const int K,
                    const int pm, const int pn, unsigned char* smem, float* part) {
  LAS bfraw* shm = (LAS bfraw*)smem;
  float* sR = (float*)(smem + 131072);
  const int tid = otid512();
#define SA(b, h) (shm + ((b) * 2 + (h)) * GHT)
#define SB(b, h) (shm + (4 + (b) * 2 + (h)) * GHT)
#define STAGE(P, BASE, br, kt) do { const char* _ub = (const char*)((BASE) + (long)(br) * LD + (long)(kt) * GBK); \
    __builtin_amdgcn_global_load_lds((const unsigned*)(_ub + voff0), (LAS unsigned*)((LAS char*)(P) + wvb), 16, 0, 0); \
    __builtin_amdgcn_global_load_lds((const unsigned*)(_ub + voff1), (LAS unsigned*)((LAS char*)(P) + wvb + 8192), 16, 0, 0); } while (0)
#define LDA(dst, b, h) _Pragma("unroll") for (int m = 0; m < 4; ++m) _Pragma("unroll") for (int k = 0; k < 2; ++k) \
    dst[m][k] = *reinterpret_cast<const LAS bf16x8*>((const LAS char*)SA(b, h) + lds_byte(wr * 64 + m * 16 + fr, k * 32 + fq * 8))
#define LDB(dst, b, h) _Pragma("unroll") for (int n = 0; n < 2; ++n) _Pragma("unroll") for (int k = 0; k < 2; ++k) \
    dst[n][k] = *reinterpret_cast<const LAS bf16x8*>((const LAS char*)SB(b, h) + lds_byte(wc * 32 + n * 16 + fr, k * 32 + fq * 8))
#define MMA(ai, bj, At, Bq) do { __builtin_amdgcn_s_setprio(1); \
    _Pragma("unroll") for (int m = 0; m < 4; ++m) _Pragma("unroll") for (int n = 0; n < 2; ++n) _Pragma("unroll") for (int k = 0; k < 2; ++k) \
      acc[ai][bj][m][n] = __builtin_amdgcn_mfma_f32_16x16x32_bf16(Bq[n][k], At[m][k], acc[ai][bj][m][n], 0, 0, 0); \
    __builtin_amdgcn_s_setprio(0); } while (0)
#define WAIT_V(n) asm volatile("s_waitcnt vmcnt(" #n ")" ::: "memory")
#define WAIT_L(n) asm volatile("s_waitcnt lgkmcnt(" #n ")" ::: "memory")
#define BAR __builtin_amdgcn_s_barrier()
#define SCHED __builtin_amdgcn_sched_barrier(0)

  const int brow = pm * 256, bcol = pn * 256;
  const int wvb = __builtin_amdgcn_readfirstlane(tid >> 6) * 1024;
  unsigned voff0, voff1;
  { int _r, _c; stage_rc(tid * 16, _r, _c); voff0 = (unsigned)(_r * LD + _c) * 2u; stage_rc(tid * 16 + 8192, _r, _c); voff1 = (unsigned)(_r * LD + _c) * 2u; }
  const int wid = tid >> 6, lane = tid & 63, wr = wid >> 2, wc = wid & 3, fr = lane & 15, fq = lane >> 4;
  __syncthreads();
  if (EPI == EPI_IN || EPI == EPI_GU) {
    if (tid < 256) {
      const float4* q = (const float4*)(p.ssq + (size_t)(brow + tid) * 16);
      float4 a = q[0], b = q[1], c = q[2], d = q[3];
      float s = ((a.x + a.y) + (a.z + a.w)) + ((b.x + b.y) + (b.z + b.w)) + ((c.x + c.y) + (c.z + c.w)) + ((d.x + d.y) + (d.z + d.w));
      sR[tid] = rsqrtf(s * (1.f / 1024.f) + EPS);
    }
  }
  WAIT_V(0);
  f32x4 acc[2][2][4][2];
#pragma unroll
  for (int a = 0; a < 2; ++a)
#pragma unroll
    for (int b = 0; b < 2; ++b)
#pragma unroll
      for (int m = 0; m < 4; ++m)
#pragma unroll
        for (int n = 0; n < 2; ++n) acc[a][b][m][n] = (f32x4){0.f, 0.f, 0.f, 0.f};
  bf16x8 At[4][2], B0[2][2], B1[2][2];
  const int nt = K / GBK;
  STAGE(SB(0, 0), Bt, bcol, 0); STAGE(SA(0, 0), A, brow, 0);
  STAGE(SB(0, 1), Bt, bcol + GHALF, 0); STAGE(SA(0, 1), A, brow + GHALF, 0);
  if (wr == 1) BAR;
  WAIT_V(4); BAR;
  STAGE(SB(1, 0), Bt, bcol, 1); STAGE(SA(1, 0), A, brow, 1); STAGE(SB(1, 1), Bt, bcol + GHALF, 1);
  WAIT_V(6); BAR;
#pragma unroll 1
  for (int t = 0; t < nt - 2; t += 2) {
    LDB(B0, 0, 0); SCHED; LDA(At, 0, 0); STAGE(SA(1, 1), A, brow + GHALF, t + 1);
    WAIT_L(8); BAR; WAIT_L(0); MMA(0, 0, At, B0); BAR; SCHED;
    LDB(B1, 0, 1); STAGE(SB(0, 0), Bt, bcol, t + 2);
    BAR; WAIT_L(0); MMA(0, 1, At, B1); BAR;
    LDA(At, 0, 1); STAGE(SA(0, 0), A, brow, t + 2);
    BAR; WAIT_L(0); MMA(1, 0, At, B0); BAR; SCHED;
    STAGE(SB(0, 1), Bt, bcol + GHALF, t + 2);
    WAIT_V(6); BAR; MMA(1, 1, At, B1); BAR;
    LDB(B0, 1, 0); SCHED; LDA(At, 1, 0); STAGE(SA(0, 1), A, brow + GHALF, t + 2);
    WAIT_L(8); BAR; WAIT_L(0); MMA(0, 0, At, B0); BAR; SCHED;
    LDB(B1, 1, 1); STAGE(SB(1, 0), Bt, bcol, t + 3);
    BAR; WAIT_L(0); MMA(0, 1, At, B1); BAR;
    LDA(At, 1, 1); STAGE(SA(1, 0), A, brow, t + 3);
    BAR; WAIT_L(0); MMA(1, 0, At, B0); BAR; SCHED;
    STAGE(SB(1, 1), Bt, bcol + GHALF, t + 3);
    WAIT_V(6); BAR; MMA(1, 1, At, B1); BAR;
  }
  { LDB(B0, 0, 0); LDA(At, 0, 0); STAGE(SA(1, 1), A, brow + GHALF, nt - 1);
    BAR; WAIT_L(0); MMA(0, 0, At, B0); BAR;
    LDB(B1, 0, 1); BAR; WAIT_L(0); MMA(0, 1, At, B1); BAR;
    LDA(At, 0, 1); WAIT_V(4); BAR; WAIT_L(0); MMA(1, 0, At, B0); MMA(1, 1, At, B1); BAR; }
  { LDB(B0, 1, 0); LDA(At, 1, 0); WAIT_V(2); BAR; WAIT_L(0); MMA(0, 0, At, B0); BAR;
    LDB(B1, 1, 1); WAIT_V(0); BAR; WAIT_L(0); MMA(0, 1, At, B1); BAR;
    LDA(At, 1, 1); BAR; WAIT_L(0); MMA(1, 0, At, B0); MMA(1, 1, At, B1); BAR; }
  if (wr == 0) BAR;
#undef SA
#undef SB
#undef STAGE
#undef LDA
#undef LDB
#undef MMA
#undef WAIT_V
#undef WAIT_L
#undef BAR
#undef SCHED

  if (EPI == EPI_IN) {
    bfraw* z = p.zh;
#pragma unroll
    for (int bj = 0; bj < 2; ++bj) {
      const int tc = bcol + bj * 128 + (wc >> 1) * 64 + (wc & 1) * 16 + fq * 4;
      const bool rope = (tc >= 1536) && (tc < 2176);
      const bool isga = (tc >= 2304);
      const int trow = (tc >= 256 && tc < 1024) ? (tc - 256) : ((tc >= 2176 && tc < 2304) ? (768 + tc - 2176) : -1);
#pragma unroll
      for (int ai = 0; ai < 2; ++ai)
#pragma unroll
        for (int m = 0; m < 4; ++m) {
          const int rl = ai * 128 + wr * 64 + m * 16 + fr;
          const int mrow = brow + rl;
          const float rs = sR[rl];
          f32x4 x1 = acc[ai][bj][m][0] * rs, x2 = acc[ai][bj][m][1] * rs;
          if (isga) {
            if (tc < 2320) *(f32x4*)(p.ga + (size_t)mrow * 16 + (tc - 2304)) = x1;
          } else {
            if (rope) {
              const int pos = (mrow < MP) ? (mrow & (SEQ - 1)) : (SEQ + ((mrow - MP) & 3));
              const float4* cp = (const float4*)(p.rope + pos * 32 + (tc & 31));
              const float4 c01 = cp[0], c23 = cp[1];
              f32x4 y1, y2;
              y1[0] = x1[0] * c01.x - x2[0] * c01.y; y2[0] = x2[0] * c01.x + x1[0] * c01.y;
              y1[1] = x1[1] * c01.z - x2[1] * c01.w; y2[1] = x2[1] * c01.z + x1[1] * c01.w;
              y1[2] = x1[2] * c23.x - x2[2] * c23.y; y2[2] = x2[2] * c23.x + x1[2] * c23.y;
              y1[3] = x1[3] * c23.z - x2[3] * c23.w; y2[3] = x2[3] * c23.z + x1[3] * c23.w;
              x1 = y1; x2 = y2;
            }
            uint2 o1, o2;
            o1.x = pack2(x1[0], x1[1]); o1.y = pack2(x1[2], x1[3]);
            o2.x = pack2(x2[0], x2[1]); o2.y = pack2(x2[2], x2[3]);
            *(uint2*)(z + (size_t)mrow * ZC + tc) = o1;
            *(uint2*)(z + (size_t)mrow * ZC + tc + 32) = o2;
            if (trow >= 0) {
              bfraw* zt = p.zT + (size_t)trow * ZTP + mrow;
              zt[0] = (bfraw)(o1.x & 0xffffu); zt[(size_t)ZTP] = (bfraw)(o1.x >> 16);
              zt[(size_t)2 * ZTP] = (bfraw)(o1.y & 0xffffu); zt[(size_t)3 * ZTP] = (bfraw)(o1.y >> 16);
              zt[(size_t)32 * ZTP] = (bfraw)(o2.x & 0xffffu); zt[(size_t)33 * ZTP] = (bfraw)(o2.x >> 16);
              zt[(size_t)34 * ZTP] = (bfraw)(o2.y & 0xffffu); zt[(size_t)35 * ZTP] = (bfraw)(o2.y >> 16);
            }
          }
        }
    }
  } else if (EPI == EPI_RES) {
#pragma unroll
    for (int ai = 0; ai < 2; ++ai)
#pragma unroll
      for (int m = 0; m < 4; ++m) {
        const int mrow = brow + ai * 128 + wr * 64 + m * 16 + fr;
        float ss = 0.f;
#pragma unroll
        for (int bj = 0; bj < 2; ++bj)
#pragma unroll
          for (int n = 0; n < 2; ++n) {
            const size_t idx = (size_t)mrow * 1024 + bcol + bj * 128 + wc * 32 + n * 16 + fq * 4;
            const uint2 xr = *(const uint2*)(p.xb + idx);
            f32x4 v = acc[ai][bj][m][n];
            v[0] += __uint_as_float(xr.x << 16); v[1] += __uint_as_float(xr.x & 0xffff0000u);
            v[2] += __uint_as_float(xr.y << 16); v[3] += __uint_as_float(xr.y & 0xffff0000u);
            uint2 o; o.x = pack2(v[0], v[1]); o.y = pack2(v[2], v[3]);
            *(uint2*)(p.xb + idx) = o;
            ss += v[0] * v[0] + v[1] * v[1] + v[2] * v[2] + v[3] * v[3];
          }
        ss += shx(ss, 16); ss += shx(ss, 32);
        if (fq == 0) p.ssq[(size_t)mrow * 16 + pn * 4 + wc] = ss;
      }
  } else if (EPI == EPI_PART) {
#pragma unroll
    for (int ai = 0; ai < 2; ++ai)
#pragma unroll
      for (int m = 0; m < 4; ++m) {
        const int r = brow - MP + ai * 128 + wr * 64 + m * 16 + fr;
#pragma unroll
        for (int bj = 0; bj < 2; ++bj)
#pragma unroll
          for (int n = 0; n < 2; ++n)
            *(f32x4*)(part + (size_t)r * 1024 + bcol + bj * 128 + wc * 32 + n * 16 + fq * 4) = acc[ai][bj][m][n];
      }
  } else {
    bfraw* hid = p.zh;
#pragma unroll
    for (int bj = 0; bj < 2; ++bj) {
      const int hc = 16 * (8 * pn + 4 * bj + wc) + fq * 4;
#pragma unroll
      for (int ai = 0; ai < 2; ++ai)
#pragma unroll
        for (int m = 0; m < 4; ++m) {
          const int rl = ai * 128 + wr * 64 + m * 16 + fr;
          const float rs = sR[rl];
          const f32x4 g = acc[ai][bj][m][0] * rs, u = acc[ai][bj][m][1] * rs;
          uint2 o;
          o.x = pack2(silu_f(g[0]) * u[0], silu_f(g[1]) * u[1]);
          o.y = pack2(silu_f(g[2]) * u[2], silu_f(g[3]) * u[3]);
          *(uint2*)(hid + (size_t)(brow + rl) * DFF + hc) = o;
        }
    }
  }
}

DEVI void unit_from_list(int L, int NU, int& pm, int& pn) {
  const int full = 64 * NU;
  if (L < full) { const int g = L / (4 * NU), rem = L - g * 4 * NU; pn = rem >> 2; pm = g * 4 + (rem & 3); }
  else { const int r = L - full; pn = r >> 1; pm = 64 + (r & 1); }
}
template <int EPI>
DEVI void gemm_phase(const Params& p, int l, const bfraw* A, const bfraw* Bt, int K, int NU, unsigned char* smem, unsigned* qctr, int qlo, int qhi) {
  const int nunits = (M_TOK / 256) * NU;
  const int x = blockIdx.x & 7, j = blockIdx.x >> 3, nj = gridDim.x >> 3;
  const int chunk = (nunits + 7) >> 3;
  const int lo = x * chunk, hi = (lo + chunk < nunits) ? lo + chunk : nunits;
  for (int L = lo + j; L < hi; L += nj) {
    int pm, pn;
    unit_from_list(L, NU, pm, pn);
    gemm_unit<EPI>(p, l, A, Bt, K, K, pm, pn, smem, nullptr);
  }
  if (qctr) {
    volatile unsigned* sQ = (volatile unsigned*)(smem + 2 * 73728 - 96);
    const int t512 = otid512(), vh = (t512 >> 8) & 1;
    for (;;) {
      __syncthreads();
      if (t512 == 0) *sQ = __hip_atomic_fetch_add(qctr, 2u, __ATOMIC_RELAXED, __HIP_MEMORY_SCOPE_AGENT);
      __syncthreads();
      const int base = qlo + (int)*sQ;
      if (base >= qhi) break;
      transpose_item(p, base + vh, smem + vh * 73728);
    }
  }
}
DEVI void gemm_res_phase(const Params& p, int l, const bfraw* A, const bfraw* Bt, int K, int nsplit, unsigned char* smem) {
  const int x = blockIdx.x & 7, j = blockIdx.x >> 3, nj = gridDim.x >> 3;
  for (int L = x * 32 + j; L < x * 32 + 32; L += nj) {
    int pm, pn;
    unit_from_list(L, 4, pm, pn);
    gemm_unit<EPI_RES>(p, l, A, Bt, K, K, pm, pn, smem, nullptr);
  }
  for (int q = j; q < nsplit; q += nj) {
    const int piece = x * nsplit + q, su = piece / nsplit, ks = piece - su * nsplit;
    gemm_unit<EPI_PART>(p, l, A + ks * 256, Bt + ks * 256, K, 256, 64 + (su >> 2), su & 3, smem, p.U + (size_t)ks * 512 * 1024);
  }
}
template <int NS>
DEVI void fin_wave(const Params& p, int wi) {
  const int lane = lane_id();
  const int r = wi >> 2, q = wi & 3, m = MP + r, c = q * 256 + lane * 4;
  const uint2 xr = *(const uint2*)(p.xb + (size_t)m * 1024 + c);
  float4 pv[NS];
#pragma unroll
  for (int ks = 0; ks < NS; ++ks) pv[ks] = *(const float4*)(p.U + ((size_t)ks * 512 + r) * 1024 + c);
  float4 v = make_float4(__uint_as_float(xr.x << 16), __uint_as_float(xr.x & 0xffff0000u), __uint_as_float(xr.y << 16), __uint_as_float(xr.y & 0xffff0000u));
#pragma unroll
  for (int ks = 0; ks < NS; ++ks) { v.x += pv[ks].x; v.y += pv[ks].y; v.z += pv[ks].z; v.w += pv[ks].w; }
  uint2 o; o.x = pack2(v.x, v.y); o.y = pack2(v.z, v.w);
  *(uint2*)(p.xb + (size_t)m * 1024 + c) = o;
  float ss = v.x * v.x + v.y * v.y + v.z * v.z + v.w * v.w;
  ss = sum64(ss);
  if (lane < 4) p.ssq[(size_t)m * 16 + q * 4 + lane] = (lane == 0) ? ss : 0.f;
}

DEVI void swa_prompt_wave(const Params& p, int l, int wi) {
  const int lane = lane_id(), fr = lane & 15, fq = lane >> 4;
  const int g = wi & 7, kvh = (wi >> 3) & 1, n = (wi >> 4) & 63, bb = wi >> 10;
  const bfraw* z = p.zh;
  const int mq0 = bb * SEQ + n * 128, r0 = g * 16;
  bf16x8 kf[10][2];
#pragma unroll
  for (int c = 0; c < 10; ++c) {
    const int il = 32 * (c >> 1) + (fr >> 2) * 8 + (c & 1) * 4 + (fr & 3);
    int tok = mq0 - 128 + r0 + il; tok = tok < 0 ? 0 : tok;
    const bfraw* kp = z + (size_t)tok * ZC + 2048 + kvh * 64 + fq * 8;
    kf[c][0] = *(const bf16x8*)(kp); kf[c][1] = *(const bf16x8*)(kp + 32);
  }
  bf16x8 vf[5][4];
  {
    const bfraw* vT = p.zT + (size_t)(768 + kvh * 64 + fr) * ZTP;
    const int tokb = mq0 - 128 + r0 + fq * 8;
#pragma unroll
    for (int pr = 0; pr < 5; ++pr) {
      int t0 = tokb + 32 * pr; t0 = t0 < 0 ? 0 : t0;
#pragma unroll
      for (int dt = 0; dt < 4; ++dt) vf[pr][dt] = *(const bf16x8*)(vT + (size_t)(dt * 16) * ZTP + t0);
    }
  }
  const bfraw* qbase = z + (size_t)(mq0 + r0 + fr) * ZC + 1536 + kvh * 256 + fq * 8;
  bf16x8 qn0 = *(const bf16x8*)(qbase), qn1 = *(const bf16x8*)(qbase + 32);
  asm volatile("" ::: "memory");
#pragma unroll 1
  for (int hq = 0; hq < 4; ++hq) {
    const int h = kvh * 4 + hq;
    const bf16x8 q0 = qn0, q1 = qn1;
    {
      const bfraw* qp = qbase + ((hq + 1) & 3) * 64;
      qn0 = *(const bf16x8*)(qp); qn1 = *(const bf16x8*)(qp + 32);
    }
    const float sink = p.sinks[l * 8 + h];
    f32x4 s[10];
#pragma unroll
    for (int c = 0; c < 10; ++c) {
      f32x4 a = (f32x4){0.f, 0.f, 0.f, 0.f};
      a = __builtin_amdgcn_mfma_f32_16x16x32_bf16(kf[c][0], q0, a, 0, 0, 0);
      a = __builtin_amdgcn_mfma_f32_16x16x32_bf16(kf[c][1], q1, a, 0, 0, 0);
      s[c] = a;
    }
    float m = -INFINITY;
#pragma unroll
    for (int c = 0; c < 10; ++c)
#pragma unroll
      for (int j = 0; j < 4; ++j) {
        const int il = 32 * (c >> 1) + fq * 8 + (c & 1) * 4 + j;
        const bool ok = (fr < il) && (il <= fr + 128) && ((n > 0) || (r0 + il >= 128));
        const float v = ok ? s[c][j] : -INFINITY;
        s[c][j] = v;
        m = fmaxf(m, v);
      }
    m = fmaxf(m, shx(m, 16)); m = fmaxf(m, shx(m, 32));
    m = fmaxf(m, sink);
    float sm = 0.f;
#pragma unroll
    for (int c = 0; c < 10; ++c)
#pragma unroll
      for (int j = 0; j < 4; ++j) { const float pv = __expf(s[c][j] - m); s[c][j] = pv; sm += pv; }
    sm += shx(sm, 16); sm += shx(sm, 32);
    const float inv = 1.f / (sm + __expf(sink - m));
    f32x4 o[4];
#pragma unroll
    for (int dt = 0; dt < 4; ++dt) o[dt] = (f32x4){0.f, 0.f, 0.f, 0.f};
#pragma unroll
    for (int pr = 0; pr < 5; ++pr) {
      union { bf16x8 v; unsigned u[4]; } pb;
      pb.u[0] = pack2(s[2 * pr][0], s[2 * pr][1]); pb.u[1] = pack2(s[2 * pr][2], s[2 * pr][3]);
      pb.u[2] = pack2(s[2 * pr + 1][0], s[2 * pr + 1][1]); pb.u[3] = pack2(s[2 * pr + 1][2], s[2 * pr + 1][3]);
#pragma unroll
      for (int dt = 0; dt < 4; ++dt) o[dt] = __builtin_amdgcn_mfma_f32_16x16x32_bf16(vf[pr][dt], pb.v, o[dt], 0, 0, 0);
    }
    bfraw* op = p.ocat + (size_t)(mq0 + r0 + fr) * 1024 + 512 + h * 64 + fq * 4;
#pragma unroll
    for (int dt = 0; dt < 4; ++dt) {
      uint2 u; u.x = pack2(o[dt][0] * inv, o[dt][1] * inv); u.y = pack2(o[dt][2] * inv, o[dt][3] * inv);
      *(uint2*)(op + dt * 16) = u;
    }
  }
}
DEVI void prompt_cache_copy(const Params& p, int l, int vb, int nvb) {
  const int tid = otid();
  for (int idx = vb * 256 + tid; idx < 2 * 128 * 2 * 64 * 2; idx += nvb * 256) {
    const int d = idx & 63, kvh = (idx >> 6) & 1, w = (idx >> 7) & 127, bb = (idx >> 14) & 1, isv = idx >> 15;
    const float v = bf2f(p.zh[(size_t)(bb * SEQ + SEQ - 128 + w) * ZC + (isv ? 2176 : 2048) + kvh * 64 + d]);
    p.out[(isv ? O_PCV : O_PCK) + ((((size_t)l * 2 + bb) * 128 + w) * 2 + kvh) * 64 + d] = v;
  }
}

DEVI void swa_sample_item(const Params& p, int l, int it, unsigned char* smem, HalfBar& hb) {
  const int tid = otid();
  const int kvh = it & 1, bs = it >> 1;
  const bfraw* z = p.zh;
  float* Ks = (float*)smem;
  float* Qs = (float*)(smem + 34560);
  float* Ss = (float*)(smem + 34560 + 4096);
  float* Rd = (float*)(smem + 34560 + 4096 + 8448);
  const int mrow0 = MP + bs * 4;
  half_sync(hb);
  {
    const int sub = tid & 15, i0 = tid >> 4;
    float4 kreg[9];
#pragma unroll
    for (int j = 0; j < 8; ++j) kreg[j] = ntld4(p.cache_k + ((((size_t)l * 128 + bs) * 128 + i0 + 16 * j) * 2 + kvh) * 64 + sub * 4);
    {
      const uint2 u = *(const uint2*)(z + (size_t)(mrow0 + (i0 & 3)) * ZC + 2048 + kvh * 64 + sub * 4);
      kreg[8] = make_float4(__uint_as_float(u.x << 16), __uint_as_float(u.x & 0xffff0000u), __uint_as_float(u.y << 16), __uint_as_float(u.y & 0xffff0000u));
    }
#pragma unroll
    for (int j = 0; j < 9; ++j) {
      const int i = i0 + 16 * j;
      if (j < 8 || i0 < 4) {
        const float4 v = kreg[j];
        Ks[i * 65 + sub * 4 + 0] = v.x; Ks[i * 65 + sub * 4 + 1] = v.y; Ks[i * 65 + sub * 4 + 2] = v.z; Ks[i * 65 + sub * 4 + 3] = v.w;
        if (i >= 4) ntst4(v, p.out + O_SCK + ((((size_t)l * 128 + bs) * 128 + (i - 4)) * 2 + kvh) * 64 + sub * 4);
      }
    }
    {
      const int row = tid >> 4, hq = row >> 2, t = row & 3;
      uint2 u = *(const uint2*)(z + (size_t)(mrow0 + t) * ZC + 1536 + (kvh * 4 + hq) * 64 + sub * 4);
      *(float4*)(Qs + row * 64 + sub * 4) = make_float4(__uint_as_float(u.x << 16), __uint_as_float(u.x & 0xffff0000u), __uint_as_float(u.y << 16), __uint_as_float(u.y & 0xffff0000u));
    }
  }
  half_sync(hb);
  for (int idx = tid; idx < 16 * 132; idx += 256) {
    const int row = idx / 132, i = idx - row * 132, t = row & 3;
    float s = 0.f;
#pragma unroll 16
    for (int d = 0; d < 64; ++d) s += Qs[row * 64 + d] * Ks[i * 65 + d];
    const bool ok = (t < i) && (i <= 128 + t);
    Ss[row * 132 + i] = ok ? s : -INFINITY;
  }
  half_sync(hb);
  {
    const int row = tid >> 4, c = tid & 15, hq = row >> 2;
    const float sink = p.sinks[l * 8 + kvh * 4 + hq];
    float m = -INFINITY;
    for (int i = c; i < 132; i += 16) m = fmaxf(m, Ss[row * 132 + i]);
    m = max16(m);
    m = fmaxf(m, sink);
    float sm = 0.f;
    for (int i = c; i < 132; i += 16) { float pv = __expf(Ss[row * 132 + i] - m); Ss[row * 132 + i] = pv; sm += pv; }
    sm = sum16(sm);
    if (c == 0) Rd[row] = 1.f / (sm + __expf(sink - m));
  }
  {
    const int sub = tid & 15, i0 = tid >> 4;
    const float* vbase = p.cache_v + ((((size_t)l * 128 + bs) * 128 + i0) * 2 + kvh) * 64 + sub * 4;
    float* obase = p.out + O_SCV + ((((size_t)l * 128 + bs) * 128 + i0) * 2 + kvh) * 64 + sub * 4;
#define VLD(j) const float4 vr##j = ntld4(vbase + (size_t)(16 * j) * 128);
    VLD(0) VLD(1) VLD(2) VLD(3) VLD(4) VLD(5) VLD(6) VLD(7)
#undef VLD
    const uint2 u8 = *(const uint2*)(z + (size_t)(mrow0 + (i0 & 3)) * ZC + 2176 + kvh * 64 + sub * 4);
    const float4 vr8 = make_float4(__uint_as_float(u8.x << 16), __uint_as_float(u8.x & 0xffff0000u), __uint_as_float(u8.y << 16), __uint_as_float(u8.y & 0xffff0000u));
#define VST(j) { *(float4*)(Ks + (i0 + 16 * j) * 64 + sub * 4) = vr##j; if (i0 + 16 * j >= 4) ntst4(vr##j, obase + ((ptrdiff_t)(16 * j) - 4) * 128); }
    VST(0) VST(1) VST(2) VST(3) VST(4) VST(5) VST(6) VST(7)
    if (i0 < 4) VST(8)
#undef VST
  }
  half_sync(hb);
  {
    const int row = tid >> 4, d4 = (tid & 15) * 4, hq = row >> 2, t = row & 3;
    float4 o = make_float4(0.f, 0.f, 0.f, 0.f);
    for (int i = 0; i < 132; ++i) {
      const float pv = Ss[row * 132 + i];
      const float4 v = *(const float4*)(Ks + i * 64 + d4);
      o.x += pv * v.x; o.y += pv * v.y; o.z += pv * v.z; o.w += pv * v.w;
    }
    const float rd = Rd[row];
    uint2 u; u.x = pack2(o.x * rd, o.y * rd); u.y = pack2(o.z * rd, o.w * rd);
    *(uint2*)(p.ocat + (size_t)(mrow0 + t) * 1024 + 512 + (kvh * 4 + hq) * 64 + d4) = u;
  }
}

DEVI void gla_gate_cumsum(const Params& p, int l, int h, int m0, float* bS, float* w2S, float* gaS, float* tot, HalfBar& hb) {
  const int tid = otid();
  for (int i = tid; i < 16 * 64; i += 256) w2S[i] = p.w_gk2[((size_t)l * 16 + (i >> 6)) * 256 + h * 64 + (i & 63)];
  if (tid < 64) w2S[1024 + tid] = p.b_gk2[l * 256 + h * 64 + tid];
  *(float4*)(gaS + tid * 4) = *(const float4*)(p.ga + (size_t)m0 * 16 + tid * 4);
  half_sync(hb);
  const int k = tid & 63, seg = tid >> 6;
  {
    float wk[16];
#pragma unroll
    for (int r = 0; r < 16; ++r) wk[r] = w2S[r * 64 + k];
    const float bias = w2S[1024 + k];
    float run = 0.f;
#pragma unroll 4
    for (int tt = 0; tt < 16; ++tt) {
      const int t = seg * 16 + tt;
      float x = bias;
#pragma unroll
      for (int r = 0; r < 16; ++r) x += gaS[t * 16 + r] * wk[r];
      run += logsig(x) * (1.f / 16.f);
      bS[t * 65 + k] = run;
    }
    tot[seg * 64 + k] = run;
  }
  half_sync(hb);
  {
    float off = 0.f;
    for (int sg = 0; sg < seg; ++sg) off += tot[sg * 64 + k];
#pragma unroll 4
    for (int tt = 0; tt < 16; ++tt) {
      const int t = seg * 16 + tt;
      const float v = bS[t * 65 + k] + off;
      bS[t * 65 + k] = v;
      p.bbuf[(size_t)(m0 + t) * 256 + h * 64 + k] = v;
    }
  }
  half_sync(hb);
}

DEVI void gla_chunk_item(const Params& p, int l, int it, unsigned char* smem, HalfBar& hb) {
  const int tid = otid(), lane = tid & 63, w = tid >> 6, fr = lane & 15, fq = lane >> 4;
  const int h = it & 3, n = (it >> 2) & 127, bb = it >> 9;
  const int m0 = bb * SEQ + n * 64;
  float* bS = (float*)smem;
  float* w2S = (float*)(smem + 16640);
  float* gaS = (float*)(smem + 16640 + 4352);
  float* tot = (float*)(smem + 16640 + 4352 + 4096);
  half_sync(hb);
  gla_gate_cumsum(p, l, h, m0, bS, w2S, gaS, tot, hb);
  const int k = 16 * w + fr;
  const float bl = bS[63 * 65 + k];
  bf16x8 af[2];
#pragma unroll
  for (int ks = 0; ks < 2; ++ks) {
    const uint4 kraw = *(const uint4*)(p.zT + (size_t)(h * 64 + k) * ZTP + m0 + ks * 32 + fq * 8);
    float f[8];
    unpack8(kraw, f);
    union { bf16x8 v; unsigned u[4]; } a;
#pragma unroll
    for (int e = 0; e < 4; ++e) {
      const int s0 = ks * 32 + fq * 8 + 2 * e;
      a.u[e] = pack2(f[2 * e] * __expf(bl - bS[s0 * 65 + k]), f[2 * e + 1] * __expf(bl - bS[(s0 + 1) * 65 + k]));
    }
    af[ks] = a.v;
  }
  float* Up = p.U + ((size_t)(bb * 128 + n) * 4 + h) * 8192;
#pragma unroll
  for (int vt = 0; vt < 8; ++vt) {
    const bfraw* vp = p.zT + (size_t)(256 + h * 128 + vt * 16 + fr) * ZTP + m0 + fq * 8;
    const bf16x8 v0 = *(const bf16x8*)(vp), v1 = *(const bf16x8*)(vp + 32);
    f32x4 acc = (f32x4){0.f, 0.f, 0.f, 0.f};
    acc = __builtin_amdgcn_mfma_f32_16x16x32_bf16(af[0], v0, acc, 0, 0, 0);
    acc = __builtin_amdgcn_mfma_f32_16x16x32_bf16(af[1], v1, acc, 0, 0, 0);
    *(f32x4*)(Up + (size_t)(vt * 16 + fr) * 64 + 16 * w + fq * 4) = acc;
  }
  if (tid < 64) p.dn[((size_t)(bb * 128 + n) * 4 + h) * 64 + tid] = __expf(bS[63 * 65 + tid]);
}

DEVI void gla_scan_item(const Params& p, int l, int it) {
  const int e = it * 256 + otid();
  const int bb = e >> 15, rem = e & 32767, h = rem >> 13, vk = rem & 8191, k = vk & 63, v = vk >> 6;
  float S = 0.f;
  float ua[16], da[16], ub[16], db[16];
#define SCAN_LOAD(U_, D_, N0) _Pragma("unroll") for (int j = 0; j < 16; ++j) { \
      U_[j] = __builtin_nontemporal_load(p.U + ((size_t)(bb * 128 + (N0) + j) * 4 + h) * 8192 + vk); \
      D_[j] = p.dn[((size_t)(bb * 128 + (N0) + j) * 4 + h) * 64 + k]; }
#define SCAN_PROC(U_, D_, N0) _Pragma("unroll") for (int j = 0; j < 16; ++j) { \
      p.Sp[((size_t)(bb * 128 + (N0) + j) * 4 + h) * 8192 + vk] = f2bf(S); S = D_[j] * S + U_[j]; }
  SCAN_LOAD(ua, da, 0)
#pragma unroll 1
  for (int n0 = 0; n0 < 128; n0 += 32) {
    SCAN_LOAD(ub, db, n0 + 16)
    SCAN_PROC(ua, da, n0)
    if (n0 + 32 < 128) { SCAN_LOAD(ua, da, n0 + 32) }
    SCAN_PROC(ub, db, n0 + 16)
  }
#undef SCAN_LOAD
#undef SCAN_PROC
  p.out[O_PSG + (((size_t)l * 2 + bb) * 4 + h) * 8192 + k * 128 + v] = S;
}

DEVI void gla_out_wave(const Params& p, int l, int wi) {
  const int lane = lane_id(), fr = lane & 15, fq = lane >> 4;
  const int half = wi & 1, h = (wi >> 1) & 3, n = (wi >> 3) & 127, bb = wi >> 10;
  const int m0 = bb * SEQ + n * 64;
  const bfraw* z = p.zh;
  uint4 kraw[2][2][2]; float4 kb[2][2][2][2];
#pragma unroll
  for (int pr = 0; pr < 2; ++pr)
#pragma unroll
    for (int ab = 0; ab < 2; ++ab) {
      const int ms = m0 + 32 * pr + (fr >> 2) * 8 + ab * 4 + (fr & 3);
#pragma unroll
      for (int ks = 0; ks < 2; ++ks) {
        kraw[pr][ab][ks] = *(const uint4*)(z + (size_t)ms * ZC + 256 + h * 64 + ks * 32 + fq * 8);
        kb[pr][ab][ks][0] = *(const float4*)(p.bbuf + (size_t)ms * 256 + h * 64 + ks * 32 + fq * 8);
        kb[pr][ab][ks][1] = *(const float4*)(p.bbuf + (size_t)ms * 256 + h * 64 + ks * 32 + fq * 8 + 4);
      }
    }
  uint4 qraw[2][2]; float4 qb[2][2][2];
#pragma unroll
  for (int ti = 0; ti < 2; ++ti) {
    const int m = m0 + (half * 2 + ti) * 16 + fr;
#pragma unroll
    for (int ks = 0; ks < 2; ++ks) {
      qraw[ti][ks] = *(const uint4*)(z + (size_t)m * ZC + h * 64 + ks * 32 + fq * 8);
      qb[ti][ks][0] = *(const float4*)(p.bbuf + (size_t)m * 256 + h * 64 + ks * 32 + fq * 8);
      qb[ti][ks][1] = *(const float4*)(p.bbuf + (size_t)m * 256 + h * 64 + ks * 32 + fq * 8 + 4);
    }
  }
  asm volatile("" ::: "memory");
  bf16x8 kt[2][2][2], qt[2][2];
#pragma unroll
  for (int pr = 0; pr < 2; ++pr)
#pragma unroll
    for (int ab = 0; ab < 2; ++ab)
#pragma unroll
      for (int ks = 0; ks < 2; ++ks) {
        float f[8];
        unpack8(kraw[pr][ab][ks], f);
        const float4 b0 = kb[pr][ab][ks][0], b1 = kb[pr][ab][ks][1];
        union { bf16x8 v; unsigned u[4]; } kk;
        kk.u[0] = pack2(f[0] * __expf(-b0.x), f[1] * __expf(-b0.y)); kk.u[1] = pack2(f[2] * __expf(-b0.z), f[3] * __expf(-b0.w));
        kk.u[2] = pack2(f[4] * __expf(-b1.x), f[5] * __expf(-b1.y)); kk.u[3] = pack2(f[6] * __expf(-b1.z), f[7] * __expf(-b1.w));
        kt[pr][ab][ks] = kk.v;
      }
#pragma unroll
  for (int ti = 0; ti < 2; ++ti)
#pragma unroll
    for (int ks = 0; ks < 2; ++ks) {
      float f[8];
      unpack8(qraw[ti][ks], f);
      const float4 b0 = qb[ti][ks][0], b1 = qb[ti][ks][1];
      union { bf16x8 v; unsigned u[4]; } a;
      a.u[0] = pack2(f[0] * __expf(b0.x), f[1] * __expf(b0.y)); a.u[1] = pack2(f[2] * __expf(b0.z), f[3] * __expf(b0.w));
      a.u[2] = pack2(f[4] * __expf(b1.x), f[5] * __expf(b1.y)); a.u[3] = pack2(f[6] * __expf(b1.z), f[7] * __expf(b1.w));
      qt[ti][ks] = a.v;
    }
  asm volatile("" ::: "memory");
  f32x4 o[2][8];
  {
    bf16x8 sf[8][2];
    const bfraw* sp = p.Sp + ((size_t)(bb * 128 + n) * 4 + h) * 8192 + (size_t)fr * 64 + fq * 8;
#pragma unroll
    for (int vt = 0; vt < 8; ++vt) { sf[vt][0] = *(const bf16x8*)(sp + vt * 1024); sf[vt][1] = *(const bf16x8*)(sp + vt * 1024 + 32); }
#pragma unroll
    for (int ti = 0; ti < 2; ++ti)
#pragma unroll
      for (int vt = 0; vt < 8; ++vt) {
        f32x4 a = (f32x4){0.f, 0.f, 0.f, 0.f};
        a = __builtin_amdgcn_mfma_f32_16x16x32_bf16(sf[vt][0], qt[ti][0], a, 0, 0, 0);
        a = __builtin_amdgcn_mfma_f32_16x16x32_bf16(sf[vt][1], qt[ti][1], a, 0, 0, 0);
        o[ti][vt] = a;
      }
  }
  asm volatile("" ::: "memory");
  bf16x8 vfr[2][8];
#pragma unroll
  for (int pr = 0; pr < 2; ++pr)
#pragma unroll
    for (int vt = 0; vt < 8; ++vt)
      vfr[pr][vt] = *(const bf16x8*)(p.zT + (size_t)(256 + h * 128 + vt * 16 + fr) * ZTP + m0 + pr * 32 + fq * 8);
#pragma unroll
  for (int ti = 0; ti < 2; ++ti) {
    const int t = (half * 2 + ti) * 16 + fr;
#pragma unroll
    for (int pr = 0; pr < 2; ++pr) {
      f32x4 at[2];
#pragma unroll
      for (int ab = 0; ab < 2; ++ab) {
        f32x4 a = (f32x4){0.f, 0.f, 0.f, 0.f};
        a = __builtin_amdgcn_mfma_f32_16x16x32_bf16(kt[pr][ab][0], qt[ti][0], a, 0, 0, 0);
        a = __builtin_amdgcn_mfma_f32_16x16x32_bf16(kt[pr][ab][1], qt[ti][1], a, 0, 0, 0);
#pragma unroll
        for (int j = 0; j < 4; ++j) {
          const int sidx = 32 * pr + fq * 8 + ab * 4 + j;
          a[j] = (sidx <= t) ? a[j] : 0.f;
        }
        at[ab] = a;
      }
      union { bf16x8 v; unsigned u[4]; } pb;
      pb.u[0] = pack2(at[0][0], at[0][1]); pb.u[1] = pack2(at[0][2], at[0][3]);
      pb.u[2] = pack2(at[1][0], at[1][1]); pb.u[3] = pack2(at[1][2], at[1][3]);
#pragma unroll
      for (int vt = 0; vt < 8; ++vt) o[ti][vt] = __builtin_amdgcn_mfma_f32_16x16x32_bf16(vfr[pr][vt], pb.v, o[ti][vt], 0, 0, 0);
    }
  }
  asm volatile("" ::: "memory");
#pragma unroll
  for (int ti = 0; ti < 2; ++ti) {
    const int m = m0 + (half * 2 + ti) * 16 + fr;
    uint2 gu[8];
#pragma unroll
    for (int vt = 0; vt < 8; ++vt) gu[vt] = *(const uint2*)(z + (size_t)m * ZC + 1024 + h * 128 + vt * 16 + fq * 4);
    float ss = 0.f;
#pragma unroll
    for (int vt = 0; vt < 8; ++vt) ss += o[ti][vt][0] * o[ti][vt][0] + o[ti][vt][1] * o[ti][vt][1] + o[ti][vt][2] * o[ti][vt][2] + o[ti][vt][3] * o[ti][vt][3];
    ss += shx(ss, 16); ss += shx(ss, 32);
    const float rs = rsqrtf(ss * (1.f / 128.f) + EPS);
#pragma unroll
    for (int vt = 0; vt < 8; ++vt) {
      const int v = vt * 16 + fq * 4;
      const float4 gn = *(const float4*)(p.gla_norm + l * 128 + v);
      const float g0 = __uint_as_float(gu[vt].x << 16), g1 = __uint_as_float(gu[vt].x & 0xffff0000u);
      const float g2 = __uint_as_float(gu[vt].y << 16), g3 = __uint_as_float(gu[vt].y & 0xffff0000u);
      uint2 ou;
      ou.x = pack2(o[ti][vt][0] * rs * gn.x * silu_f(g0), o[ti][vt][1] * rs * gn.y * silu_f(g1));
      ou.y = pack2(o[ti][vt][2] * rs * gn.z * silu_f(g2), o[ti][vt][3] * rs * gn.w * silu_f(g3));
      *(uint2*)(p.ocat + (size_t)m * 1024 + h * 128 + v) = ou;
    }
  }
}

DEVI void gla_sample_item(const Params& p, int l, int it, unsigned char* smem, HalfBar& hb) {
  const int tid = otid(), lane = tid & 63, w = tid >> 6;
  const int h = it & 3, bs = it >> 2;
  const bfraw* z = p.zh;
  float* eS = (float*)smem;
  float* qS = eS + 256;
  float* kS = qS + 256;
  float* vS = kS + 256;
  float* oS = vS + 512;
  const int mrow0 = MP + bs * 4;
  float S[32];
  {
    const float* sp = p.state_gla + ((((size_t)l * 128 + bs) * 4 + h) * 64 + (tid >> 7) * 32) * 128 + (tid & 127);
#pragma unroll
    for (int i = 0; i < 32; ++i) S[i] = __builtin_nontemporal_load(sp + (size_t)i * 128);
  }
  const float g0r = bf2f(z[(size_t)(mrow0 + w) * ZC + 1024 + h * 128 + lane]), g1r = bf2f(z[(size_t)(mrow0 + w) * ZC + 1024 + h * 128 + 64 + lane]);
  half_sync(hb);
  {
    const int t = w, k = lane;
    const float* gp = p.ga + (size_t)(mrow0 + t) * 16;
    float x = p.b_gk2[l * 256 + h * 64 + k];
#pragma unroll
    for (int r = 0; r < 16; ++r) x += gp[r] * p.w_gk2[((size_t)l * 16 + r) * 256 + h * 64 + k];
    eS[t * 64 + k] = __expf(logsig(x) * (1.f / 16.f));
    qS[t * 64 + k] = bf2f(z[(size_t)(mrow0 + t) * ZC + h * 64 + k]);
    kS[t * 64 + k] = bf2f(z[(size_t)(mrow0 + t) * ZC + 256 + h * 64 + k]);
    vS[t * 128 + k] = bf2f(z[(size_t)(mrow0 + t) * ZC + 512 + h * 128 + k]);
    vS[t * 128 + 64 + k] = bf2f(z[(size_t)(mrow0 + t) * ZC + 512 + h * 128 + 64 + k]);
  }
  half_sync(hb);
  {
    const int v = tid & 127, half = tid >> 7;
#pragma unroll
    for (int t = 0; t < 4; ++t) {
      const float vv = vS[t * 128 + v];
      float op = 0.f;
#pragma unroll
      for (int i = 0; i < 32; ++i) {
        const int k = half * 32 + i;
        S[i] = eS[t * 64 + k] * S[i] + kS[t * 64 + k] * vv;
        op += qS[t * 64 + k] * S[i];
      }
      oS[(t * 2 + half) * 128 + v] = op;
    }
    float* so = p.out + O_SSG + ((((size_t)l * 128 + bs) * 4 + h) * 64 + half * 32) * 128 + v;
#pragma unroll
    for (int i = 0; i < 32; ++i) __builtin_nontemporal_store(S[i], so + (size_t)i * 128);
  }
  half_sync(hb);
  {
    const int t = w;
    float o0 = oS[(t * 2) * 128 + lane] + oS[(t * 2 + 1) * 128 + lane];
    float o1 = oS[(t * 2) * 128 + 64 + lane] + oS[(t * 2 + 1) * 128 + 64 + lane];
    float ss = sum64(o0 * o0 + o1 * o1);
    const float rs = rsqrtf(ss * (1.f / 128.f) + EPS);
    const float g0 = g0r, g1 = g1r;
    bfraw* op = p.ocat + (size_t)(mrow0 + t) * 1024 + h * 128;
    op[lane] = f2bf(o0 * rs * p.gla_norm[l * 128 + lane] * silu_f(g0));
    op[64 + lane] = f2bf(o1 * rs * p.gla_norm[l * 128 + 64 + lane] * silu_f(g1));
  }
}

DEVI void final_item(const Params& p, int it) {
  const int tid = otid(), lane = tid & 63, w = tid >> 6;
  const int m = it * 4 + w;
  const float4* q = (const float4*)(p.ssq + (size_t)m * 16);
  float4 a = q[0], b = q[1], c = q[2], d = q[3];
  float s = ((a.x + a.y) + (a.z + a.w)) + ((b.x + b.y) + (b.z + b.w)) + ((c.x + c.y) + (c.z + c.w)) + ((d.x + d.y) + (d.z + d.w));
  const float rs = rsqrtf(s * (1.f / 1024.f) + EPS);
#pragma unroll
  for (int i = 0; i < 4; ++i) {
    const int col = lane * 4 + i * 256;
    const uint2 xr = *(const uint2*)(p.xb + (size_t)m * 1024 + col);
    float4 v = make_float4(__uint_as_float(xr.x << 16), __uint_as_float(xr.x & 0xffff0000u), __uint_as_float(xr.y << 16), __uint_as_float(xr.y & 0xffff0000u));
    const float4 g = *(const float4*)(p.norm_final + col);
    v.x *= rs * g.x; v.y *= rs * g.y; v.z *= rs * g.z; v.w *= rs * g.w;
    ntst4(v, p.out + (size_t)m * 1024 + col);
  }
}

DEVI void run_phase(const Params& p, int ph, unsigned char* smem_all, int rep) {
  const int l = (ph - 1) / 9, s = (ph - 1) % 9;
  if (ph > 0 && ph < NPHASE - 1 && (s == 0 || s == 4 || s == 6 || s == 7)) {
    unsigned* qc = (l < 3) ? (p.qctr + (l * 2 + (s == 6)) * 16) : nullptr;
    if (s == 0) gemm_phase<EPI_IN>(p, l, p.xb, p.WinT + (size_t)l * NINP * 1024, 1024, 10, smem_all, qc, (l + 1) * 3008, (l + 1) * 3008 + 1760);
    else if (s == 6) gemm_phase<EPI_GU>(p, l, p.xb, p.WguT + (size_t)l * 5632 * 1024, 1024, 22, smem_all, qc, (l + 1) * 3008 + 1760, (l + 2) * 3008);
    else {
      const bool dn = (s == 7);
      gemm_res_phase(p, l, dn ? p.zh : p.ocat, dn ? (p.WdT + (size_t)l * 1024 * 2816) : (p.WoT + (size_t)l * 1024 * 1024),
                     dn ? DFF : 1024, dn ? 11 : 4, smem_all);
    }
    return;
  }
  const int vh = (otid512() >> 8) & 1;
  const int vb = blockIdx.x * 2 + vh, nvb = gridDim.x * 2;
  unsigned char* smem = smem_all + vh * 73728;
  if (ph == 0) { phase_prologue(p, smem, vb, nvb); return; }
  if (ph == NPHASE - 1) {
    for (int it = vb; it < M_TOK / 4; it += nvb) final_item(p, it);
    return;
  }
  switch (s) {
    case 1: {
      HalfBar hb; hb.cnt = (volatile LAS unsigned*)(smem_all + 2 * 73728 - 64 + vh * 32); hb.target = *hb.cnt;
      __syncthreads();
      if (vh == 0) {
        for (int it = blockIdx.x; it < 768; it += gridDim.x) {
          if (it < 512) gla_sample_item(p, l, it, smem, hb);
          else swa_sample_item(p, l, it - 512, smem, hb);
        }
      } else {
        for (int it = blockIdx.x; it < 1024; it += gridDim.x) gla_chunk_item(p, l, it, smem, hb);
      }
      prompt_cache_copy(p, l, vb, nvb);
      {
        const int wg = blockIdx.x * 8 + __builtin_amdgcn_readfirstlane(otid512() >> 6), nw = gridDim.x * 8;
        for (int wi = wg; wi < 2048; wi += nw) swa_prompt_wave(p, l, wi);
      }
    } break;
    case 2:
      for (int it = vb; it < 256; it += nvb) gla_scan_item(p, l, it);
      break;
    case 3: {
      const int wg = blockIdx.x * 8 + __builtin_amdgcn_readfirstlane(otid512() >> 6), nw = gridDim.x * 8;
      for (int wi = wg; wi < 2048; wi += nw) gla_out_wave(p, l, wi);
      {
        const uint4* wp = (const uint4*)(p.WoT + (size_t)l * 1024 * 1024) + (size_t)wg * 64 + lane_id();
        uint4 w0 = *wp;
        asm volatile("" :: "v"(w0.x), "v"(w0.y), "v"(w0.z), "v"(w0.w));
      }
    } break;
    case 5: {
      const int wg = blockIdx.x * 8 + __builtin_amdgcn_readfirstlane(otid512() >> 6), nw = gridDim.x * 8;
      for (int wi = wg; wi < 2048; wi += nw) fin_wave<4>(p, wi);
    } break;
    case 8: {
      const int wg = blockIdx.x * 8 + __builtin_amdgcn_readfirstlane(otid512() >> 6), nw = gridDim.x * 8;
      for (int wi = wg; wi < 2048; wi += nw) fin_wave<11>(p, wi);
    } break;
  }
}

__global__ void __launch_bounds__(512, 2) mega_kernel(Params p, int ph_lo, int ph_hi) {
  __shared__ __attribute__((aligned(16))) unsigned char smem[2 * 73728];
  uint4* xb_words = (uint4*)(smem + 2 * 73728 - 16);
  if (otid512() == 0) { *xb_words = make_uint4(0u, 0u, 0u, 0u); *(uint4*)(smem + 2 * 73728 - 64) = make_uint4(0u, 0u, 0u, 0u); *(uint4*)(smem + 2 * 73728 - 32) = make_uint4(0u, 0u, 0u, 0u); }
  __syncthreads();
  XcdBarrier xb = xcd_barrier_post(p.bar, (volatile LAS unsigned*)xb_words);
  if (ph_hi < 0) cg::this_grid().sync();
  for (int ph = ph_lo; ph < ph_hi; ++ph) {
    int reps = 1;
#ifdef DUP_MASK
    if (ph > 0 && ph < NPHASE - 1 && ((DUP_MASK >> ((ph - 1) % 9)) & 1)) reps = 2;
#endif
#ifdef DUP_PRO
    if (ph == 0) reps = 2;
#endif
    for (int r = 0; r < reps; ++r) {
      run_phase(p, ph, smem, r);
      if (ph + 1 < ph_hi || r + 1 < reps) xcd_barrier(xb);
    }
#ifdef DUP_SYNC
    if (ph > 0 && ph < NPHASE - 1) xcd_barrier(xb);
#endif
  }
}

extern "C" void kernel_launch(void* const* d_in, const int* in_sizes, int n_in, void* d_out, int out_size, void* d_ws,
                              size_t ws_size, hipStream_t stream) {
  static int grid_blocks = 0;
  if (!grid_blocks) {
    int dev = 0, cus = 0, per_cu = 0;
    hipGetDevice(&dev);
    hipDeviceGetAttribute(&cus, hipDeviceAttributeMultiprocessorCount, dev);
    hipOccupancyMaxActiveBlocksPerMultiprocessor(&per_cu, mega_kernel, 512, 0);
    if (per_cu < 1) per_cu = 1;
    if (per_cu > 1) per_cu = 1;
    grid_blocks = cus * per_cu;
  }
  Params p{};
  p.x_prompt = (const float*)d_in[0]; p.x_sample = (const float*)d_in[1]; p.state_gla = (const float*)d_in[2];
  p.cache_k = (const float*)d_in[3]; p.cache_v = (const float*)d_in[4]; p.norm_attn = (const float*)d_in[5];
  p.w_in = (const float*)d_in[6]; p.w_gk2 = (const float*)d_in[7]; p.b_gk2 = (const float*)d_in[8];
  p.gla_norm = (const float*)d_in[9]; p.sinks = (const float*)d_in[10]; p.w_o = (const float*)d_in[11];
  p.norm_ffn = (const float*)d_in[12]; p.w_gate = (const float*)d_in[13]; p.w_up = (const float*)d_in[14];
  p.w_down = (const float*)d_in[15]; p.norm_final = (const float*)d_in[16];
  p.out = (float*)d_out;
  unsigned char* ws = (unsigned char*)d_ws;
  size_t off = 0;
  auto take = [&](size_t bytes) { unsigned char* r = ws + off; off += (bytes + 255) & ~(size_t)255; return r; };
  p.WinT = (bfraw*)take((size_t)4 * NINP * 1024 * 2);
  p.WoT = (bfraw*)take((size_t)4 * 1024 * 1024 * 2);
  p.WguT = (bfraw*)take((size_t)4 * 5632 * 1024 * 2);
  p.WdT = (bfraw*)take((size_t)4 * 1024 * 2816 * 2);
  p.xb = (bfraw*)take((size_t)M_TOK * 1024 * 2);
  p.zh = (bfraw*)take((size_t)M_TOK * DFF * 2);
  p.ocat = (bfraw*)take((size_t)M_TOK * 1024 * 2);
  p.zT = (bfraw*)take((size_t)896 * ZTP * 2);
  p.ssq = (float*)take((size_t)M_TOK * 16 * 4);
  p.ga = (float*)take((size_t)M_TOK * 16 * 4);
  p.U = (float*)take((size_t)2 * 128 * 4 * 8192 * 4);
  p.dn = (float*)take((size_t)2 * 128 * 4 * 64 * 4);
  p.Sp = (bfraw*)take((size_t)2 * 128 * 4 * 8192 * 2);
  p.bbuf = (float*)take((size_t)MP * 256 * 4);
  p.rope = (float2*)take((size_t)8196 * 32 * 8);
  p.bar = (unsigned*)take((size_t)(XCD_BAR_WORDS + 256) * 4);
  p.qctr = p.bar + XCD_BAR_WORDS;
  if (off > ws_size) { fprintf(stderr, "workspace too small: need %zu have %zu\n", off, ws_size); return; }
  (void)hipMemsetAsync(p.bar, 0, (size_t)(XCD_BAR_WORDS + 256) * 4, stream);
#if MULTI_LAUNCH
  for (int ph = 0; ph < NPHASE; ++ph) {
    hipLaunchKernelGGL(mega_kernel, dim3(grid_blocks), dim3(512), 0, stream, p, ph, ph + 1);
  }
#else
  int lo = 0, hi = NPHASE;
  void* args[] = {&p, &lo, &hi};
  hipError_t e = hipLaunchCooperativeKernel((void*)mega_kernel, dim3(grid_blocks), dim3(512), args, 0, stream);
  if (e != hipSuccess) fprintf(stderr, "cooperative launch failed: %s (grid %d)\n", hipGetErrorString(e), grid_blocks);
#endif
}
```

```cpp
#include <hip/hip_runtime.h>
#include <hip/hip_bf16.h>
#include <hip/hip_cooperative_groups.h>
#include <cstdio>
namespace cg = cooperative_groups;

#ifndef MULTI_LAUNCH
#define MULTI_LAUNCH 0
#endif

typedef unsigned short bfraw;
using bf16x8 = __attribute__((ext_vector_type(8))) short;
using f32x4  = __attribute__((ext_vector_type(4))) float;
#define DEVI __device__ __forceinline__
#define LAS __attribute__((address_space(3)))

constexpr int M_TOK = 16896, MP = 16384, DM = 1024, ZC = 2304, NINP = 2560, DFF = 2816, SEQ = 8192;
constexpr int NPHASE = 38;
constexpr int ZTP = M_TOK + 64;
constexpr float EPS = 1e-6f;

constexpr size_t O_YP = 0, O_PSG = 17301504, O_PCK = 17563648, O_PCV = 17694720,
                 O_SSG = 17825792, O_SCK = 34603008, O_SCV = 42991616;

struct Params {
  const float *x_prompt, *x_sample, *state_gla, *cache_k, *cache_v, *norm_attn, *w_in, *w_gk2, *b_gk2,
              *gla_norm, *sinks, *w_o, *norm_ffn, *w_gate, *w_up, *w_down, *norm_final;
  float* out;
  bfraw *WinT, *WoT, *WguT, *WdT, *xb, *zh, *ocat, *zT;
  float *ssq, *ga, *U, *dn, *bbuf;
  bfraw* Sp;
  float2* rope;
  unsigned* bar;
  unsigned* qctr;
};

DEVI int lane_id() { int l; asm volatile("v_mbcnt_lo_u32_b32 %0, -1, 0\n\tv_mbcnt_hi_u32_b32 %0, -1, %0" : "=v"(l)); return l; }
DEVI int otid512() { const int w = __builtin_amdgcn_readfirstlane((int)(threadIdx.x >> 6)); return w * 64 + lane_id(); }
DEVI int otid() { return otid512() & 255; }
struct HalfBar { volatile LAS unsigned* cnt; unsigned target; };
DEVI void half_sync(HalfBar& hb) {
  asm volatile("s_waitcnt lgkmcnt(0)" ::: "memory");
  hb.target += 4u;
  if (lane_id() == 0) __hip_atomic_fetch_add((LAS unsigned*)hb.cnt, 1u, __ATOMIC_RELAXED, __HIP_MEMORY_SCOPE_WORKGROUP);
  while (*hb.cnt < hb.target) __builtin_amdgcn_s_sleep(0);
  asm volatile("s_waitcnt lgkmcnt(0)" ::: "memory");
}
DEVI float4 ntld4(const float* p) { const f32x4 v = __builtin_nontemporal_load((const f32x4*)p); return make_float4(v[0], v[1], v[2], v[3]); }
DEVI void ntst4(float4 v, float* p) { f32x4 w = {v.x, v.y, v.z, v.w}; __builtin_nontemporal_store(w, (f32x4*)p); }
DEVI float shx(float v, int mask) { const int l = lane_id(); return __int_as_float(__builtin_amdgcn_ds_bpermute((l ^ mask) << 2, __float_as_int(v))); }
DEVI bfraw f2bf(float f) { unsigned u = __float_as_uint(f); u += 0x7fffu + ((u >> 16) & 1u); return (bfraw)(u >> 16); }
DEVI float bf2f(bfraw h) { return __uint_as_float(((unsigned)h) << 16); }
typedef __bf16 bf16v2_t __attribute__((ext_vector_type(2)));
typedef float f32v2_t __attribute__((ext_vector_type(2)));
DEVI unsigned pack2(float a, float b) { f32v2_t v = {a, b}; bf16v2_t r = __builtin_convertvector(v, bf16v2_t); return __builtin_bit_cast(unsigned, r); }
DEVI float sum16(float v) { v += shx(v, 1); v += shx(v, 2); v += shx(v, 4); v += shx(v, 8); return v; }
DEVI float max16(float v) { v = fmaxf(v, shx(v, 1)); v = fmaxf(v, shx(v, 2)); v = fmaxf(v, shx(v, 4)); v = fmaxf(v, shx(v, 8)); return v; }
DEVI float sum64(float v) { v = sum16(v); v += shx(v, 16); v += shx(v, 32); return v; }
DEVI float silu_f(float x) { return __fdividef(x, 1.f + __expf(-x)); }
DEVI float logsig(float x) { return fminf(x, 0.f) - __logf(1.f + __expf(-fabsf(x))); }
DEVI void unpack8(uint4 u, float* f) {
  f[0] = __uint_as_float(u.x << 16); f[1] = __uint_as_float(u.x & 0xffff0000u);
  f[2] = __uint_as_float(u.y << 16); f[3] = __uint_as_float(u.y & 0xffff0000u);
  f[4] = __uint_as_float(u.z << 16); f[5] = __uint_as_float(u.z & 0xffff0000u);
  f[6] = __uint_as_float(u.w << 16); f[7] = __uint_as_float(u.w & 0xffff0000u);
}


#define XB_TMO      128
#define XB_XCNT(j)  (256  + 64 * (j))
#define XB_XSUB(j)  (1280 + 64 * (j))
#define XB_XGEN(j)  (2304 + 64 * (j))
#define XB_TOP      3328
#define XB_TOPGEN   3392
#define XCD_BAR_WORDS 3456
#define XB_SPIN_CAP (1u << 22)
DEVI unsigned xb_ld(unsigned* p)              { return __hip_atomic_load(p, __ATOMIC_RELAXED, __HIP_MEMORY_SCOPE_AGENT); }
DEVI unsigned xb_add(unsigned* p, unsigned v) { return __hip_atomic_fetch_add(p, v, __ATOMIC_RELAXED, __HIP_MEMORY_SCOPE_AGENT); }
DEVI unsigned xb_xcc_id() { return (unsigned)__builtin_amdgcn_s_getreg((3 << 11) | 20) & 0xFu; }
#define XB_SPIN(cond, bar) do { unsigned _sp = 0; while (cond) { __builtin_amdgcn_s_sleep(1); \
    if ((++_sp & 255u) == 0u) { if (xb_ld(&(bar)[XB_TMO])) break; if (_sp > XB_SPIN_CAP) { atomicAdd(&(bar)[XB_TMO], 1u); break; } } } } while (0)
struct XcdBarrier { unsigned* bar; unsigned x; volatile LAS unsigned* st; };
DEVI XcdBarrier xcd_barrier_post(unsigned* bar, volatile LAS unsigned* st) {
  XcdBarrier b; b.bar = bar; b.x = xb_xcc_id(); b.st = st;
  if (otid512() == 0) (void)xb_add(&bar[XB_XCNT(b.x)], 1u);
  return b;
}
DEVI void xcd_barrier_complete(unsigned* bar, unsigned x, unsigned& nloc, unsigned& nx) {
  const unsigned G = gridDim.x * gridDim.y * gridDim.z;
  unsigned sum, cnt, mine, sp = 0u;
  for (;;) {
    sum = 0u; cnt = 0u; mine = 0u;
#pragma unroll
    for (unsigned j = 0; j < 16; ++j) { const unsigned c = xb_ld(&bar[XB_XCNT(j)]); sum += c; cnt += (c > 0u) ? 1u : 0u; mine = (j == x) ? c : mine; }
    if (sum == G) break;
    __builtin_amdgcn_s_sleep(1);
    if ((++sp & 255u) == 0u) { if (xb_ld(&bar[XB_TMO])) break; if (sp > XB_SPIN_CAP) { atomicAdd(&bar[XB_TMO], 1u); break; } }
  }
  nloc = mine > 0u ? mine : 1u; nx = cnt > 0u ? cnt : 1u;
}
DEVI void xcd_barrier(const XcdBarrier& b) {
  asm volatile("s_waitcnt vmcnt(0)" ::: "memory");
  __syncthreads();
  if (otid512() == 0) {
    unsigned* bar = b.bar;
    __builtin_amdgcn_s_waitcnt(0);
    unsigned nloc = b.st[0], nx = b.st[1];
    if (nloc == 0u) { xcd_barrier_complete(bar, b.x, nloc, nx); b.st[0] = nloc; b.st[1] = nx; }
    const unsigned old = xb_add(&bar[XB_XSUB(b.x)], 1u);
    const unsigned gen = old / nloc;
    if (old + 1u == (gen + 1u) * nloc) {
      __builtin_amdgcn_fence(__ATOMIC_RELEASE, "agent");
      asm volatile("s_waitcnt vmcnt(0)" ::: "memory");
      const unsigned og = xb_add(&bar[XB_TOP], 1u);
      const unsigned tg = og / nx;
      if (og + 1u == (tg + 1u) * nx) xb_add(&bar[XB_TOPGEN], 1u);
      else XB_SPIN(xb_ld(&bar[XB_TOPGEN]) == tg, bar);
      __builtin_amdgcn_fence(__ATOMIC_ACQUIRE, "agent");
      xb_add(&bar[XB_XGEN(b.x)], 1u);
      asm volatile("s_waitcnt vmcnt(0)" ::: "memory");
    } else {
      XB_SPIN(xb_ld(&bar[XB_XGEN(b.x)]) == gen, bar);
      __builtin_amdgcn_fence(__ATOMIC_ACQUIRE, "agent");
      asm volatile("s_waitcnt vmcnt(0)" ::: "memory");
    }
  }
  __syncthreads();
}

DEVI float4 wsrc4(const Params& p, int type, int l, int k, int r) {
  float4 v; float sc = 1.f;
  if (type == 0) {
    const int q = r & 63;
    const int n = (r & ~63) + ((q >> 5) << 4) + (q & 15) + (((q >> 4) & 1) << 5);
    int col;
    if (n < 1024) col = n; else if (n < 2304) col = n + 16; else if (n < 2320) col = n - 1280; else return make_float4(0.f, 0.f, 0.f, 0.f);
    sc = p.norm_attn[l * 1024 + k];
    if (n < 256 || (n >= 1536 && n < 2048)) sc *= 0.125f;
    v = ntld4(p.w_in + ((size_t)l * 1024 + k) * 2320 + col);
  } else if (type == 1) {
    v = ntld4(p.w_o + ((size_t)l * 1024 + k) * 1024 + r);
  } else if (type == 2) {
    const int G = r >> 5, t = r & 31;
    const float* s = (t < 16) ? p.w_gate : p.w_up;
    sc = p.norm_ffn[l * 1024 + k];
    v = ntld4(s + ((size_t)l * 1024 + k) * 2816 + G * 16 + (t & 15));
  } else {
    v = ntld4(p.w_down + ((size_t)l * 2816 + k) * 1024 + r);
  }
  v.x *= sc; v.y *= sc; v.z *= sc; v.w *= sc;
  return v;
}

DEVI void transpose_item(const Params& p, int it, unsigned char* smem) {
  float* t = (float*)smem;
  const int tid = otid();
  int l = it / 3008, r = it % 3008;
  int type, ntile, ktile, K; bfraw* dst;
  if (r < 640) { type = 0; ntile = r / 16; ktile = r % 16; K = 1024; dst = p.WinT + (size_t)l * NINP * 1024; }
  else if (r < 896) { r -= 640; type = 1; ntile = r / 16; ktile = r % 16; K = 1024; dst = p.WoT + (size_t)l * 1024 * 1024; }
  else if (r < 2304) { r -= 896; type = 2; ntile = r / 16; ktile = r % 16; K = 1024; dst = p.WguT + (size_t)l * 5632 * 1024; }
  else { r -= 2304; type = 3; ntile = r / 44; ktile = r % 44; K = 2816; dst = p.WdT + (size_t)l * 1024 * 2816; }
  const int n0 = ntile * 64, k0 = ktile * 64;
  __syncthreads();
  {
    const int nq = (tid & 15) * 4, kb = tid >> 4;
    float4 v[4];
#pragma unroll
    for (int i = 0; i < 4; ++i) v[i] = wsrc4(p, type, l, k0 + kb + 16 * i, n0 + nq);
#pragma unroll
    for (int i = 0; i < 4; ++i) {
      float* tp = t + (kb + 16 * i) * 65 + nq;
      tp[0] = v[i].x; tp[1] = v[i].y; tp[2] = v[i].z; tp[3] = v[i].w;
    }
  }
  __syncthreads();
  {
    const int kc = tid & 7;
#pragma unroll
    for (int i = 0; i < 2; ++i) {
      int nn = (tid >> 3) + 32 * i;
      float v[8];
#pragma unroll
      for (int e = 0; e < 8; ++e) v[e] = t[(kc * 8 + e) * 65 + nn];
      uint4 o; o.x = pack2(v[0], v[1]); o.y = pack2(v[2], v[3]); o.z = pack2(v[4], v[5]); o.w = pack2(v[6], v[7]);
      { typedef unsigned u32x4_t __attribute__((ext_vector_type(4))); u32x4_t ov = {o.x, o.y, o.z, o.w}; __builtin_nontemporal_store(ov, (u32x4_t*)(dst + (size_t)(n0 + nn) * K + k0 + kc * 8)); }
    }
  }
}

DEVI void xconv_item(const Params& p, int it) {
  const int tid = otid(), lane = tid & 63, w = tid >> 6;
#pragma unroll 1
  for (int ps = 0; ps < 4; ++ps) {
    int m = it * 16 + ps * 4 + w;
    const float* src = (m < MP) ? (p.x_prompt + (size_t)m * 1024) : (p.x_sample + (size_t)(m - MP) * 1024);
    float4 v[4];
#pragma unroll
    for (int i = 0; i < 4; ++i) v[i] = ntld4(src + lane * 4 + i * 256);
    float ss = 0.f;
#pragma unroll
    for (int i = 0; i < 4; ++i) {
      const int c = lane * 4 + i * 256;
      uint2 o; o.x = pack2(v[i].x, v[i].y); o.y = pack2(v[i].z, v[i].w);
      *(uint2*)(p.xb + (size_t)m * 1024 + c) = o;
      ss += v[i].x * v[i].x + v[i].y * v[i].y + v[i].z * v[i].z + v[i].w * v[i].w;
    }
    ss = sum64(ss);
    if (lane < 16) p.ssq[(size_t)m * 16 + lane] = (lane == 0) ? ss : 0.f;
  }
}

DEVI void rope_item(const Params& p, int it) {
  int idx = it * 256 + otid();
  if (idx < 8196 * 32) {
    int pos = idx >> 5, i = idx & 31;
    float inv = exp2f(-(float)i * 0.41524101186092029f);
    float ang = (float)pos * inv;
    double rev = (double)ang * 0.15915494309189535;
    rev -= rint(rev);
    float rf = (float)(rev * 6.283185307179586);
    p.rope[idx] = make_float2(__cosf(rf), __sinf(rf));
  }
}

DEVI void phase_prologue(const Params& p, unsigned char* smem, int vb, int nvb) {
  const int nT = 3008, nX = M_TOK / 16, nR = 1026;
  const int total = nT + nX + nR;
  for (int it = vb; it < total; it += nvb) {
    if (it < nT) transpose_item(p, it, smem);
    else if (it < nT + nX) xconv_item(p, it - nT);
    else rope_item(p, it - nT - nX);
  }
}

enum { EPI_IN = 0, EPI_RES = 1, EPI_GU = 2, EPI_PART = 3 };
constexpr int GBK = 64, GHALF = 128, GHT = GHALF * GBK;

DEVI int lds_byte(int r, int c) {
  int st = (r >> 4) * 2 + (c >> 5), rr = r & 15, cc = c & 31, ob = rr * 64 + cc * 2;
  return st * 1024 + (ob ^ (((ob >> 9) & 1) << 5));
}
DEVI void stage_rc(int b, int& R, int& C) {
  int st = b / 1024, sb = b % 1024, swz = sb ^ (((sb >> 9) & 1) << 5);
  R = (st >> 1) * 16 + swz / 64; C = (st & 1) * 32 + (swz % 64) / 2;
}

template <int EPI>
DEVI void gemm_unit(const Params& p, int l, const bfraw* A, const bfraw* Bt, const int LD, const int K,
                    const int pm, const int pn, unsigned char* smem, float* part) {
  LAS bfraw* shm = (LAS bfraw*)smem;
  float* sR = (float*)(smem + 131072);
  const int tid = otid512();
#define SA(b, h) (shm + ((b) * 2 + (h)) * GHT)
#define SB(b, h) (shm + (4 + (b) * 2 + (h)) * GHT)
#define STAGE(P, BASE, br, kt) do { const char* _ub = (const char*)((BASE) + (long)(br) * LD + (long)(kt) * GBK); \
    __builtin_amdgcn_global_load_lds((const unsigned*)(_ub + voff0), (LAS unsigned*)((LAS char*)(P) + wvb), 16, 0, 0); \
    __builtin_amdgcn_global_load_lds((const unsigned*)(_ub + voff1), (LAS unsigned*)((LAS char*)(P) + wvb + 8192), 16, 0, 0); } while (0)
#define LDA(dst, b, h) _Pragma("unroll") for (int m = 0; m < 4; ++m) _Pragma("unroll") for (int k = 0; k < 2; ++k) \
    dst[m][k] = *reinterpret_cast<const LAS bf16x8*>((const LAS char*)SA(b, h) + lds_byte(wr * 64 + m * 16 + fr, k * 32 + fq * 8))
#define LDB(dst, b, h) _Pragma("unroll") for (int n = 0; n < 2; ++n) _Pragma("unroll") for (int k = 0; k < 2; ++k) \
    dst[n][k] = *reinterpret_cast<const LAS bf16x8*>((const LAS char*)SB(b, h) + lds_byte(wc * 32 + n * 16 + fr, k * 32 + fq * 8))
#define MMA(ai, bj, At, Bq) do { __builtin_amdgcn_s_setprio(1); \
    _Pragma("unroll") for (int m = 0; m < 4; ++m) _Pragma("unroll") for (int n = 0; n < 2; ++n) _Pragma("unroll") for (int k = 0; k < 2; ++k) \
      acc[ai][bj][m][n] = __builtin_amdgcn_mfma_f32_16x16x32_bf16(Bq[n][k], At[m][k], acc[ai][bj][m][n], 0, 0, 0); \
    __builtin_amdgcn_s_setprio(0); } while (0)
#define WAIT_V(n) asm volatile("s_waitcnt vmcnt(" #n ")" ::: "memory")
#define WAIT_L(n) asm volatile("s_waitcnt lgkmcnt(" #n ")" ::: "memory")
#define BAR __builtin_amdgcn_s_barrier()
#define SCHED __builtin_amdgcn_sched_barrier(0)

  const int brow = pm * 256, bcol = pn * 256;
  const int wvb = __builtin_amdgcn_readfirstlane(tid >> 6) * 1024;
  unsigned voff0, voff1;
  { int _r, _c; stage_rc(tid * 16, _r, _c); voff0 = (unsigned)(_r * LD + _c) * 2u; stage_rc(tid * 16 + 8192, _r, _c); voff1 = (unsigned)(_r * LD + _c) * 2u; }
  const int wid = tid >> 6, lane = tid & 63, wr = wid >> 2, wc = wid & 3, fr = lane & 15, fq = lane >> 4;
  __syncthreads();
  if (EPI == EPI_IN || EPI == EPI_GU) {
    if (tid < 256) {
      const float4* q = (const float4*)(p.ssq + (size_t)(brow + tid) * 16);
      float4 a = q[0], b = q[1], c = q[2], d = q[3];
      float s = ((a.x + a.y) + (a.z + a.w)) + ((b.x + b.y) + (b.z + b.w)) + ((c.x + c.y) + (c.z + c.w)) + ((d.x + d.y) + (d.z + d.w));
      sR[tid] = rsqrtf(s * (1.f / 1024.f) + EPS);
    }
  }
  WAIT_V(0);
  f32x4 acc[2][2][4][2];
#pragma unroll
  for (int a = 0; a < 2; ++a)
#pragma unroll
    for (int b = 0; b < 2; ++b)
#pragma unroll
      for (int m = 0; m < 4; ++m)
#pragma unroll
        for (int n = 0; n < 2; ++n) acc[a][b][m][n] = (f32x4){0.f, 0.f, 0.f, 0.f};
  bf16x8 At[4][2], B0[2][2], B1[2][2];
  const int nt = K / GBK;
  STAGE(SB(0, 0), Bt, bcol, 0); STAGE(SA(0, 0), A, brow, 0);
  STAGE(SB(0, 1), Bt, bcol + GHALF, 0); STAGE(SA(0, 1), A, brow + GHALF, 0);
  if (wr == 1) BAR;
  WAIT_V(4); BAR;
  STAGE(SB(1, 0), Bt, bcol, 1); STAGE(SA(1, 0), A, brow, 1); STAGE(SB(1, 1), Bt, bcol + GHALF, 1);
  WAIT_V(6); BAR;
#pragma unroll 1
  for (int t = 0; t < nt - 2; t += 2) {
    LDB(B0, 0, 0); SCHED; LDA(At, 0, 0); STAGE(SA(1, 1), A, brow + GHALF, t + 1);
    WAIT_L(8); BAR; WAIT_L(0); MMA(0, 0, At, B0); BAR; SCHED;
    LDB(B1, 0, 1); STAGE(SB(0, 0), Bt, bcol, t + 2);
    BAR; WAIT_L(0); MMA(0, 1, At, B1); BAR;
    LDA(At, 0, 1); STAGE(SA(0, 0), A, brow, t + 2);
    BAR; WAIT_L(0); MMA(1, 0, At, B0); BAR; SCHED;
    STAGE(SB(0, 1), Bt, bcol + GHALF, t + 2);
    WAIT_V(6); BAR; MMA(1, 1, At, B1); BAR;
    LDB(B0, 1, 0); SCHED; LDA(At, 1, 0); STAGE(SA(0, 1), A, brow + GHALF, t + 2);
    WAIT_L(8); BAR; WAIT_L(0); MMA(0, 0, At, B0); BAR; SCHED;
    LDB(B1, 1, 1); STAGE(SB(1, 0), Bt, bcol, t + 3);
    BAR; WAIT_L(0); MMA(0, 1, At, B1); BAR;
    LDA(At, 1, 1); STAGE(SA(1, 0), A, brow, t + 3);
    BAR; WAIT_L(0); MMA(1, 0, At, B0); BAR; SCHED;
    STAGE(SB(1, 1), Bt, bcol + GHALF, t + 3);
    WAIT_V(6); BAR; MMA(1, 1, At, B1); BAR;
  }
  { LDB(B0, 0, 0); LDA(At, 0, 0); STAGE(SA(1, 1), A, brow + GHALF, nt - 1);
    BAR; WAIT_L(0); MMA(0, 0, At, B0); BAR;
    LDB(B1, 0, 1); BAR; WAIT_L(0); MMA(0, 1, At, B1); BAR;
    LDA(At, 0, 1); WAIT_V(4); BAR; WAIT_L(0); MMA(1, 0, At, B0); MMA(1, 1, At, B1); BAR; }
  { LDB(B0, 1, 0); LDA(At, 1, 0); WAIT_V(2); BAR; WAIT_L(0); MMA(0, 0, At, B0); BAR;
    LDB(B1, 1, 1); WAIT_V(0); BAR; WAIT_L(0); MMA(0, 1, At, B1); BAR;
    LDA(At, 1, 1); BAR; WAIT_L(0); MMA(1, 0, At, B0); MMA(1, 1, At, B1); BAR; }
  if (wr == 0) BAR;
#undef SA
#undef SB
#undef STAGE
#undef LDA
#undef LDB
#undef MMA
#undef WAIT_V
#undef WAIT_L
#undef BAR
#undef SCHED

  if (EPI == EPI_IN) {
    bfraw* z = p.zh;
#pragma unroll
    for (int bj = 0; bj < 2; ++bj) {
      const int tc = bcol + bj * 128 + (wc >> 1) * 64 + (wc & 1) * 16 + fq * 4;
      const bool rope = (tc >= 1536) && (tc < 2176);
      const bool isga = (tc >= 2304);
      const int trow = (tc >= 256 && tc < 1024) ? (tc - 256) : ((tc >= 2176 && tc < 2304) ? (768 + tc - 2176) : -1);
#pragma unroll
      for (int ai = 0; ai < 2; ++ai)
#pragma unroll
        for (int m = 0; m < 4; ++m) {
          const int rl = ai * 128 + wr * 64 + m * 16 + fr;
          const int mrow = brow + rl;
          const float rs = sR[rl];
          f32x4 x1 = acc[ai][bj][m][0] * rs, x2 = acc[ai][bj][m][1] * rs;
          if (isga) {
            if (tc < 2320) *(f32x4*)(p.ga + (size_t)mrow * 16 + (tc - 2304)) = x1;
          } else {
            if (rope) {
              const int pos = (mrow < MP) ? (mrow & (SEQ - 1)) : (SEQ + ((mrow - MP) & 3));
              const float4* cp = (const float4*)(p.rope + pos * 32 + (tc & 31));
              const float4 c01 = cp[0], c23 = cp[1];
              f32x4 y1, y2;
              y1[0] = x1[0] * c01.x - x2[0] * c01.y; y2[0] = x2[0] * c01.x + x1[0] * c01.y;
              y1[1] = x1[1] * c01.z - x2[1] * c01.w; y2[1] = x2[1] * c01.z + x1[1] * c01.w;
              y1[2] = x1[2] * c23.x - x2[2] * c23.y; y2[2] = x2[2] * c23.x + x1[2] * c23.y;
              y1[3] = x1[3] * c23.z - x2[3] * c23.w; y2[3] = x2[3] * c23.z + x1[3] * c23.w;
              x1 = y1; x2 = y2;
            }
            uint2 o1, o2;
            o1.x = pack2(x1[0], x1[1]); o1.y = pack2(x1[2], x1[3]);
            o2.x = pack2(x2[0], x2[1]); o2.y = pack2(x2[2], x2[3]);
            *(uint2*)(z + (size_t)mrow * ZC + tc) = o1;
            *(uint2*)(z + (size_t)mrow * ZC + tc + 32) = o2;
            if (trow >= 0) {
              bfraw* zt = p.zT + (size_t)trow * ZTP + mrow;
              zt[0] = (bfraw)(o1.x & 0xffffu); zt[(size_t)ZTP] = (bfraw)(o1.x >> 16);
              zt[(size_t)2 * ZTP] = (bfraw)(o1.y & 0xffffu); zt[(size_t)3 * ZTP] = (bfraw)(o1.y >> 16);
              zt[(size_t)32 * ZTP] = (bfraw)(o2.x & 0xffffu); zt[(size_t)33 * ZTP] = (bfraw)(o2.x >> 16);
              zt[(size_t)34 * ZTP] = (bfraw)(o2.y & 0xffffu); zt[(size_t)35 * ZTP] = (bfraw)(o2.y >> 16);
            }
          }
        }
    }
  } else if (EPI == EPI_RES) {
#pragma unroll
    for (int ai = 0; ai < 2; ++ai)
#pragma unroll
      for (int m = 0; m < 4; ++m) {
        const int mrow = brow + ai * 128 + wr * 64 + m * 16 + fr;
        float ss = 0.f;
#pragma unroll
        for (int bj = 0; bj < 2; ++bj)
#pragma unroll
          for (int n = 0; n < 2; ++n) {
            const size_t idx = (size_t)mrow * 1024 + bcol + bj * 128 + wc * 32 + n * 16 + fq * 4;
            const uint2 xr = *(const uint2*)(p.xb + idx);
            f32x4 v = acc[ai][bj][m][n];
            v[0] += __uint_as_float(xr.x << 16); v[1] += __uint_as_float(xr.x & 0xffff0000u);
            v[2] += __uint_as_float(xr.y << 16); v[3] += __uint_as_float(xr.y & 0xffff0000u);
            uint2 o; o.x = pack2(v[0], v[1]); o.y = pack2(v[2], v[3]);
            *(uint2*)(p.xb + idx) = o;
            ss += v[0] * v[0] + v[1] * v[1] + v[2] * v[2] + v[3] * v[3];
          }
        ss += shx(ss, 16); ss += shx(ss, 32);
        if (fq == 0) p.ssq[(size_t)mrow * 16 + pn * 4 + wc] = ss;
      }
  } else if (EPI == EPI_PART) {
#pragma unroll
    for (int ai = 0; ai < 2; ++ai)
#pragma unroll
      for (int m = 0; m < 4; ++m) {
        const int r = brow - MP + ai * 128 + wr * 64 + m * 16 + fr;
#pragma unroll
        for (int bj = 0; bj < 2; ++bj)
#pragma unroll
          for (int n = 0; n < 2; ++n)
            *(f32x4*)(part + (size_t)r * 1024 + bcol + bj * 128 + wc * 32 + n * 16 + fq * 4) = acc[ai][bj][m][n];
      }
  } else {
    bfraw* hid = p.zh;
#pragma unroll
    for (int bj = 0; bj < 2; ++bj) {
      const int hc = 16 * (8 * pn + 4 * bj + wc) + fq * 4;
#pragma unroll
      for (int ai = 0; ai < 2; ++ai)
#pragma unroll
        for (int m = 0; m < 4; ++m) {
          const int rl = ai * 128 + wr * 64 + m * 16 + fr;
          const float rs = sR[rl];
          const f32x4 g = acc[ai][bj][m][0] * rs, u = acc[ai][bj][m][1] * rs;
          uint2 o;
          o.x = pack2(silu_f(g[0]) * u[0], silu_f(g[1]) * u[1]);
          o.y = pack2(silu_f(g[2]) * u[2], silu_f(g[3]) * u[3]);
          *(uint2*)(hid + (size_t)(brow + rl) * DFF + hc) = o;
        }
    }
  }
}

DEVI void unit_from_list(int L, int NU, int& pm, int& pn) {
  const int full = 64 * NU;
  if (L < full) { const int g = L / (4 * NU), rem = L - g * 4 * NU; pn = rem >> 2; pm = g * 4 + (rem & 3); }
  else { const int r = L - full; pn = r >> 1; pm = 64 + (r & 1); }
}
template <int EPI>
DEVI void gemm_phase(const Params& p, int l, const bfraw* A, const bfraw* Bt, int K, int NU, unsigned char* smem, unsigned* qctr, int qlo, int qhi) {
  const int nunits = (M_TOK / 256) * NU;
  const int x = blockIdx.x & 7, j = blockIdx.x >> 3, nj = gridDim.x >> 3;
  const int chunk = (nunits + 7) >> 3;
  const int lo = x * chunk, hi = (lo + chunk < nunits) ? lo + chunk : nunits;
  for (int L = lo + j; L < hi; L += nj) {
    int pm, pn;
    unit_from_list(L, NU, pm, pn);
    gemm_unit<EPI>(p, l, A, Bt, K, K, pm, pn, smem, nullptr);
  }
  if (qctr) {
    volatile unsigned* sQ = (volatile unsigned*)(smem + 2 * 73728 - 96);
    const int t512 = otid512(), vh = (t512 >> 8) & 1;
    for (;;) {
      __syncthreads();
      if (t512 == 0) *sQ = __hip_atomic_fetch_add(qctr, 2u, __ATOMIC_RELAXED, __HIP_MEMORY_SCOPE_AGENT);
      __syncthreads();
      const int base = qlo + (int)*sQ;
      if (base >= qhi) break;
      transpose_item(p, base + vh, smem + vh * 73728);
    }
  }
}
DEVI void gemm_res_phase(const Params& p, int l, const bfraw* A, const bfraw* Bt, int K, int nsplit, unsigned char* smem) {
  const int x = blockIdx.x & 7, j = blockIdx.x >> 3, nj = gridDim.x >> 3;
  for (int L = x * 32 + j; L < x * 32 + 32; L += nj) {
    int pm, pn;
    unit_from_list(L, 4, pm, pn);
    gemm_unit<EPI_RES>(p, l, A, Bt, K, K, pm, pn, smem, nullptr);
  }
  for (int q = j; q < nsplit; q += nj) {
    const int piece = x * nsplit + q, su = piece / nsplit, ks = piece - su * nsplit;
    gemm_unit<EPI_PART>(p, l, A + ks * 256, Bt + ks * 256, K, 256, 64 + (su >> 2), su & 3, smem, p.U + (size_t)ks * 512 * 1024);
  }
}
template <int NS>
DEVI void fin_wave(const Params& p, int wi) {
  const int lane = lane_id();
  const int r = wi >> 2, q = wi & 3, m = MP + r, c = q * 256 + lane * 4;
  const uint2 xr = *(const uint2*)(p.xb + (size_t)m * 1024 + c);
  float4 pv[NS];
#pragma unroll
  for (int ks = 0; ks < NS; ++ks) pv[ks] = *(const float4*)(p.U + ((size_t)ks * 512 + r) * 1024 + c);
  float4 v = make_float4(__uint_as_float(xr.x << 16), __uint_as_float(xr.x & 0xffff0000u), __uint_as_float(xr.y << 16), __uint_as_float(xr.y & 0xffff0000u));
#pragma unroll
  for (int ks = 0; ks < NS; ++ks) { v.x += pv[ks].x; v.y += pv[ks].y; v.z += pv[ks].z; v.w += pv[ks].w; }
  uint2 o; o.x = pack2(v.x, v.y); o.y = pack2(v.z, v.w);
  *(uint2*)(p.xb + (size_t)m * 1024 + c) = o;
  float ss = v.x * v.x + v.y * v.y + v.z * v.z + v.w * v.w;
  ss = sum64(ss);
  if (lane < 4) p.ssq[(size_t)m * 16 + q * 4 + lane] = (lane == 0) ? ss : 0.f;
}

DEVI void swa_prompt_wave(const Params& p, int l, int wi) {
  const int lane = lane_id(), fr = lane & 15, fq = lane >> 4;
  const int g = wi & 7, kvh = (wi >> 3) & 1, n = (wi >> 4) & 63, bb = wi >> 10;
  const bfraw* z = p.zh;
  const int mq0 = bb * SEQ + n * 128, r0 = g * 16;
  bf16x8 kf[10][2];
#pragma unroll
  for (int c = 0; c < 10; ++c) {
    const int il = 32 * (c >> 1) + (fr >> 2) * 8 + (c & 1) * 4 + (fr & 3);
    int tok = mq0 - 128 + r0 + il; tok = tok < 0 ? 0 : tok;
    const bfraw* kp = z + (size_t)tok * ZC + 2048 + kvh * 64 + fq * 8;
    kf[c][0] = *(const bf16x8*)(kp); kf[c][1] = *(const bf16x8*)(kp + 32);
  }
  bf16x8 vf[5][4];
  {
    const bfraw* vT = p.zT + (size_t)(768 + kvh * 64 + fr) * ZTP;
    const int tokb = mq0 - 128 + r0 + fq * 8;
#pragma unroll
    for (int pr = 0; pr < 5; ++pr) {
      int t0 = tokb + 32 * pr; t0 = t0 < 0 ? 0 : t0;
#pragma unroll
      for (int dt = 0; dt < 4; ++dt) vf[pr][dt] = *(const bf16x8*)(vT + (size_t)(dt * 16) * ZTP + t0);
    }
  }
  const bfraw* qbase = z + (size_t)(mq0 + r0 + fr) * ZC + 1536 + kvh * 256 + fq * 8;
  bf16x8 qn0 = *(const bf16x8*)(qbase), qn1 = *(const bf16x8*)(qbase + 32);
  asm volatile("" ::: "memory");
#pragma unroll 1
  for (int hq = 0; hq < 4; ++hq) {
    const int h = kvh * 4 + hq;
    const bf16x8 q0 = qn0, q1 = qn1;
    {
      const bfraw* qp = qbase + ((hq + 1) & 3) * 64;
      qn0 = *(const bf16x8*)(qp); qn1 = *(const bf16x8*)(qp + 32);
    }
    const float sink = p.sinks[l * 8 + h];
    f32x4 s[10];
#pragma unroll
    for (int c = 0; c < 10; ++c) {
      f32x4 a = (f32x4){0.f, 0.f, 0.f, 0.f};
      a = __builtin_amdgcn_mfma_f32_16x16x32_bf16(kf[c][0], q0, a, 0, 0, 0);
      a = __builtin_amdgcn_mfma_f32_16x16x32_bf16(kf[c][1], q1, a, 0, 0, 0);
      s[c] = a;
    }
    float m = -INFINITY;
#pragma unroll
    for (int c = 0; c < 10; ++c)
#pragma unroll
      for (int j = 0; j < 4; ++j) {
        const int il = 32 * (c >> 1) + fq * 8 + (c & 1) * 4 + j;
        const bool ok = (fr < il) && (il <= fr + 128) && ((n > 0) || (r0 + il >= 128));
        const float v = ok ? s[c][j] : -INFINITY;
        s[c][j] = v;
        m = fmaxf(m, v);
      }
    m = fmaxf(m, shx(m, 16)); m = fmaxf(m, shx(m, 32));
    m = fmaxf(m, sink);
    float sm = 0.f;
#pragma unroll
    for (int c = 0; c < 10; ++c)
#pragma unroll
      for (int j = 0; j < 4; ++j) { const float pv = __expf(s[c][j] - m); s[c][j] = pv; sm += pv; }
    sm += shx(sm, 16); sm += shx(sm, 32);
    const float inv = 1.f / (sm + __expf(sink - m));
    f32x4 o[4];
#pragma unroll
    for (int dt = 0; dt < 4; ++dt) o[dt] = (f32x4){0.f, 0.f, 0.f, 0.f};
#pragma unroll
    for (int pr = 0; pr < 5; ++pr) {
      union { bf16x8 v; unsigned u[4]; } pb;
      pb.u[0] = pack2(s[2 * pr][0], s[2 * pr][1]); pb.u[1] = pack2(s[2 * pr][2], s[2 * pr][3]);
      pb.u[2] = pack2(s[2 * pr + 1][0], s[2 * pr + 1][1]); pb.u[3] = pack2(s[2 * pr + 1][2], s[2 * pr + 1][3]);
#pragma unroll
      for (int dt = 0; dt < 4; ++dt) o[dt] = __builtin_amdgcn_mfma_f32_16x16x32_bf16(vf[pr][dt], pb.v, o[dt], 0, 0, 0);
    }
    bfraw* op = p.ocat + (size_t)(mq0 + r0 + fr) * 1024 + 512 + h * 64 + fq * 4;
#pragma unroll
    for (int dt = 0; dt < 4; ++dt) {
      uint2 u; u.x = pack2(o[dt][0] * inv, o[dt][1] * inv); u.y = pack2(o[dt][2] * inv, o[dt][3] * inv);
      *(uint2*)(op + dt * 16) = u;
    }
  }
}
DEVI void prompt_cache_copy(const Params& p, int l, int vb, int nvb) {
  const int tid = otid();
  for (int idx = vb * 256 + tid; idx < 2 * 128 * 2 * 64 * 2; idx += nvb * 256) {
    const int d = idx & 63, kvh = (idx >> 6) & 1, w = (idx >> 7) & 127, bb = (idx >> 14) & 1, isv = idx >> 15;
    const float v = bf2f(p.zh[(size_t)(bb * SEQ + SEQ - 128 + w) * ZC + (isv ? 2176 : 2048) + kvh * 64 + d]);
    p.out[(isv ? O_PCV : O_PCK) + ((((size_t)l * 2 + bb) * 128 + w) * 2 + kvh) * 64 + d] = v;
  }
}

DEVI void swa_sample_item(const Params& p, int l, int it, unsigned char* smem, HalfBar& hb) {
  const int tid = otid();
  const int kvh = it & 1, bs = it >> 1;
  const bfraw* z = p.zh;
  float* Ks = (float*)smem;
  float* Qs = (float*)(smem + 34560);
  float* Ss = (float*)(smem + 34560 + 4096);
  float* Rd = (float*)(smem + 34560 + 4096 + 8448);
  const int mrow0 = MP + bs * 4;
  half_sync(hb);
  {
    const int sub = tid & 15, i0 = tid >> 4;
    float4 kreg[9];
#pragma unroll
    for (int j = 0; j < 8; ++j) kreg[j] = ntld4(p.cache_k + ((((size_t)l * 128 + bs) * 128 + i0 + 16 * j) * 2 + kvh) * 64 + sub * 4);
    {
      const uint2 u = *(const uint2*)(z + (size_t)(mrow0 + (i0 & 3)) * ZC + 2048 + kvh * 64 + sub * 4);
      kreg[8] = make_float4(__uint_as_float(u.x << 16), __uint_as_float(u.x & 0xffff0000u), __uint_as_float(u.y << 16), __uint_as_float(u.y & 0xffff0000u));
    }
#pragma unroll
    for (int j = 0; j < 9; ++j) {
      const int i = i0 + 16 * j;
      if (j < 8 || i0 < 4) {
        const float4 v = kreg[j];
        Ks[i * 65 + sub * 4 + 0] = v.x; Ks[i * 65 + sub * 4 + 1] = v.y; Ks[i * 65 + sub * 4 + 2] = v.z; Ks[i * 65 + sub * 4 + 3] = v.w;
        if (i >= 4) ntst4(v, p.out + O_SCK + ((((size_t)l * 128 + bs) * 128 + (i - 4)) * 2 + kvh) * 64 + sub * 4);
      }
    }
    {
      const int row = tid >> 4, hq = row >> 2, t = row & 3;
      uint2 u = *(const uint2*)(z + (size_t)(mrow0 + t) * ZC + 1536 + (kvh * 4 + hq) * 64 + sub * 4);
      *(float4*)(Qs + row * 64 + sub * 4) = make_float4(__uint_as_float(u.x << 16), __uint_as_float(u.x & 0xffff0000u), __uint_as_float(u.y << 16), __uint_as_float(u.y & 0xffff0000u));
    }
  }
  half_sync(hb);
  for (int idx = tid; idx < 16 * 132; idx += 256) {
    const int row = idx / 132, i = idx - row * 132, t = row & 3;
    float s = 0.f;
#pragma unroll 16
    for (int d = 0; d < 64; ++d) s += Qs[row * 64 + d] * Ks[i * 65 + d];
    const bool ok = (t < i) && (i <= 128 + t);
    Ss[row * 132 + i] = ok ? s : -INFINITY;
  }
  half_sync(hb);
  {
    const int row = tid >> 4, c = tid & 15, hq = row >> 2;
    const float sink = p.sinks[l * 8 + kvh * 4 + hq];
    float m = -INFINITY;
    for (int i = c; i < 132; i += 16) m = fmaxf(m, Ss[row * 132 + i]);
    m = max16(m);
    m = fmaxf(m, sink);
    float sm = 0.f;
    for (int i = c; i < 132; i += 16) { float pv = __expf(Ss[row * 132 + i] - m); Ss[row * 132 + i] = pv; sm += pv; }
    sm = sum16(sm);
    if (c == 0) Rd[row] = 1.f / (sm + __expf(sink - m));
  }
  {
    const int sub = tid & 15, i0 = tid >> 4;
    const float* vbase = p.cache_v + ((((size_t)l * 128 + bs) * 128 + i0) * 2 + kvh) * 64 + sub * 4;
    float* obase = p.out + O_SCV + ((((size_t)l * 128 + bs) * 128 + i0) * 2 + kvh) * 64 + sub * 4;
#define VLD(j) const float4 vr##j = ntld4(vbase + (size_t)(16 * j) * 128);
    VLD(0) VLD(1) VLD(2) VLD(3) VLD(4) VLD(5) VLD(6) VLD(7)
#undef VLD
    const uint2 u8 = *(const uint2*)(z + (size_t)(mrow0 + (i0 & 3)) * ZC + 2176 + kvh * 64 + sub * 4);
    const float4 vr8 = make_float4(__uint_as_float(u8.x << 16), __uint_as_float(u8.x & 0xffff0000u), __uint_as_float(u8.y << 16), __uint_as_float(u8.y & 0xffff0000u));
#define VST(j) { *(float4*)(Ks + (i0 + 16 * j) * 64 + sub * 4) = vr##j; if (i0 + 16 * j >= 4) ntst4(vr##j, obase + ((ptrdiff_t)(16 * j) - 4) * 128); }
    VST(0) VST(1) VST(2) VST(3) VST(4) VST(5) VST(6) VST(7)
    if (i0 < 4) VST(8)
#undef VST
  }
  half_sync(hb);
  {
    const int row = tid >> 4, d4 = (tid & 15) * 4, hq = row >> 2, t = row & 3;
    float4 o = make_float4(0.f, 0.f, 0.f, 0.f);
    for (int i = 0; i < 132; ++i) {
      const float pv = Ss[row * 132 + i];
      const float4 v = *(const float4*)(Ks + i * 64 + d4);
      o.x += pv * v.x; o.y += pv * v.y; o.z += pv * v.z; o.w += pv * v.w;
    }
    const float rd = Rd[row];
    uint2 u; u.x = pack2(o.x * rd, o.y * rd); u.y = pack2(o.z * rd, o.w * rd);
    *(uint2*)(p.ocat + (size_t)(mrow0 + t) * 1024 + 512 + (kvh * 4 + hq) * 64 + d4) = u;
  }
}

DEVI void gla_gate_cumsum(const Params& p, int l, int h, int m0, float* bS, float* w2S, float* gaS, float* tot, HalfBar& hb) {
  const int tid = otid();
  for (int i = tid; i < 16 * 64; i += 256) w2S[i] = p.w_gk2[((size_t)l * 16 + (i >> 6)) * 256 + h * 64 + (i & 63)];
  if (tid < 64) w2S[1024 + tid] = p.b_gk2[l * 256 + h * 64 + tid];
  *(float4*)(gaS + tid * 4) = *(const float4*)(p.ga + (size_t)m0 * 16 + tid * 4);
  half_sync(hb);
  const int k = tid & 63, seg = tid >> 6;
  {
    float wk[16];
#pragma unroll
    for (int r = 0; r < 16; ++r) wk[r] = w2S[r * 64 + k];
    const float bias = w2S[1024 + k];
    float run = 0.f;
#pragma unroll 4
    for (int tt = 0; tt < 16; ++tt) {
      const int t = seg * 16 + tt;
      float x = bias;
#pragma unroll
      for (int r = 0; r < 16; ++r) x += gaS[t * 16 + r] * wk[r];
      run += logsig(x) * (1.f / 16.f);
      bS[t * 65 + k] = run;
    }
    tot[seg * 64 + k] = run;
  }
  half_sync(hb);
  {
    float off = 0.f;
    for (int sg = 0; sg < seg; ++sg) off += tot[sg * 64 + k];
#pragma unroll 4
    for (int tt = 0; tt < 16; ++tt) {
      const int t = seg * 16 + tt;
      const float v = bS[t * 65 + k] + off;
      bS[t * 65 + k] = v;
      p.bbuf[(size_t)(m0 + t) * 256 + h * 64 + k] = v;
    }
  }
  half_sync(hb);
}

DEVI void gla_chunk_item(const Params& p, int l, int it, unsigned char* smem, HalfBar& hb) {
  const int tid = otid(), lane = tid & 63, w = tid >> 6, fr = lane & 15, fq = lane >> 4;
  const int h = it & 3, n = (it >> 2) & 127, bb = it >> 9;
  const int m0 = bb * SEQ + n * 64;
  float* bS = (float*)smem;
  float* w2S = (float*)(smem + 16640);
  float* gaS = (float*)(smem + 16640 + 4352);
  float* tot = (float*)(smem + 16640 + 4352 + 4096);
  half_sync(hb);
  gla_gate_cumsum(p, l, h, m0, bS, w2S, gaS, tot, hb);
  const int k = 16 * w + fr;
  const float bl = bS[63 * 65 + k];
  bf16x8 af[2];
#pragma unroll
  for (int ks = 0; ks < 2; ++ks) {
    const uint4 kraw = *(const uint4*)(p.zT + (size_t)(h * 64 + k) * ZTP + m0 + ks * 32 + fq * 8);
    float f[8];
    unpack8(kraw, f);
    union { bf16x8 v; unsigned u[4]; } a;
#pragma unroll
    for (int e = 0; e < 4; ++e) {
      const int s0 = ks * 32 + fq * 8 + 2 * e;
      a.u[e] = pack2(f[2 * e] * __expf(bl - bS[s0 * 65 + k]), f[2 * e + 1] * __expf(bl - bS[(s0 + 1) * 65 + k]));
    }
    af[ks] = a.v;
  }
  float* Up = p.U + ((size_t)(bb * 128 + n) * 4 + h) * 8192;
#pragma unroll
  for (int vt = 0; vt < 8; ++vt) {
    const bfraw* vp = p.zT + (size_t)(256 + h * 128 + vt * 16 + fr) * ZTP + m0 + fq * 8;
    const bf16x8 v0 = *(const bf16x8*)(vp), v1 = *(const bf16x8*)(vp + 32);
    f32x4 acc = (f32x4){0.f, 0.f, 0.f, 0.f};
    acc = __builtin_amdgcn_mfma_f32_16x16x32_bf16(af[0], v0, acc, 0, 0, 0);
    acc = __builtin_amdgcn_mfma_f32_16x16x32_bf16(af[1], v1, acc, 0, 0, 0);
    *(f32x4*)(Up + (size_t)(vt * 16 + fr) * 64 + 16 * w + fq * 4) = acc;
  }
  if (tid < 64) p.dn[((size_t)(bb * 128 + n) * 4 + h) * 64 + tid] = __expf(bS[63 * 65 + tid]);
}

DEVI void gla_scan_item(const Params& p, int l, int it) {
  const int e = it * 256 + otid();
  const int bb = e >> 15, rem = e & 32767, h = rem >> 13, vk = rem & 8191, k = vk & 63, v = vk >> 6;
  float S = 0.f;
  float ua[16], da[16], ub[16], db[16];
#define SCAN_LOAD(U_, D_, N0) _Pragma("unroll") for (int j = 0; j < 16; ++j) { \
      U_[j] = __builtin_nontemporal_load(p.U + ((size_t)(bb * 128 + (N0) + j) * 4 + h) * 8192 + vk); \
      D_[j] = p.dn[((size_t)(bb * 128 + (N0) + j) * 4 + h) * 64 + k]; }
#define SCAN_PROC(U_, D_, N0) _Pragma("unroll") for (int j = 0; j < 16; ++j) { \
      p.Sp[((size_t)(bb * 128 + (N0) + j) * 4 + h) * 8192 + vk] = f2bf(S); S = D_[j] * S + U_[j]; }
  SCAN_LOAD(ua, da, 0)
#pragma unroll 1
  for (int n0 = 0; n0 < 128; n0 += 32) {
    SCAN_LOAD(ub, db, n0 + 16)
    SCAN_PROC(ua, da, n0)
    if (n0 + 32 < 128) { SCAN_LOAD(ua, da, n0 + 32) }
    SCAN_PROC(ub, db, n0 + 16)
  }
#undef SCAN_LOAD
#undef SCAN_PROC
  p.out[O_PSG + (((size_t)l * 2 + bb) * 4 + h) * 8192 + k * 128 + v] = S;
}

DEVI void gla_out_wave(const Params& p, int l, int wi) {
  const int lane = lane_id(), fr = lane & 15, fq = lane >> 4;
  const int half = wi & 1, h = (wi >> 1) & 3, n = (wi >> 3) & 127, bb = wi >> 10;
  const int m0 = bb * SEQ + n * 64;
  const bfraw* z = p.zh;
  uint4 kraw[2][2][2]; float4 kb[2][2][2][2];
#pragma unroll
  for (int pr = 0; pr < 2; ++pr)
#pragma unroll
    for (int ab = 0; ab < 2; ++ab) {
      const int ms = m0 + 32 * pr + (fr >> 2) * 8 + ab * 4 + (fr & 3);
#pragma unroll
      for (int ks = 0; ks < 2; ++ks) {
        kraw[pr][ab][ks] = *(const uint4*)(z + (size_t)ms * ZC + 256 + h * 64 + ks * 32 + fq * 8);
        kb[pr][ab][ks][0] = *(const float4*)(p.bbuf + (size_t)ms * 256 + h * 64 + ks * 32 + fq * 8);
        kb[pr][ab][ks][1] = *(const float4*)(p.bbuf + (size_t)ms * 256 + h * 64 + ks * 32 + fq * 8 + 4);
      }
    }
  uint4 qraw[2][2]; float4 qb[2][2][2];
#pragma unroll
  for (int ti = 0; ti < 2; ++ti) {
    const int m = m0 + (half * 2 + ti) * 16 + fr;
#pragma unroll
    for (int ks = 0; ks < 2; ++ks) {
      qraw[ti][ks] = *(const uint4*)(z + (size_t)m * ZC + h * 64 + ks * 32 + fq * 8);
      qb[ti][ks][0] = *(const float4*)(p.bbuf + (size_t)m * 256 + h * 64 + ks * 32 + fq * 8);
      qb[ti][ks][1] = *(const float4*)(p.bbuf + (size_t)m * 256 + h * 64 + ks * 32 + fq * 8 + 4);
    }
  }
  asm volatile("" ::: "memory");
  bf16x8 kt[2][2][2], qt[2][2];
#pragma unroll
  for (int pr = 0; pr < 2; ++pr)
#pragma unroll
    for (int ab = 0; ab < 2; ++ab)
#pragma unroll
      for (int ks = 0; ks < 2; ++ks) {
        float f[8];
        unpack8(kraw[pr][ab][ks], f);
        const float4 b0 = kb[pr][ab][ks][0], b1 = kb[pr][ab][ks][1];
        union { bf16x8 v; unsigned u[4]; } kk;
        kk.u[0] = pack2(f[0] * __expf(-b0.x), f[1] * __expf(-b0.y)); kk.u[1] = pack2(f[2] * __expf(-b0.z), f[3] * __expf(-b0.w));
        kk.u[2] = pack2(f[4] * __expf(-b1.x), f[5] * __expf(-b1.y)); kk.u[3] = pack2(f[6] * __expf(-b1.z), f[7] * __expf(-b1.w));
        kt[pr][ab][ks] = kk.v;
      }
#pragma unroll
  for (int ti = 0; ti < 2; ++ti)
#pragma unroll
    for (int ks = 0; ks < 2; ++ks) {
      float f[8];
      unpack8(qraw[ti][ks], f);
      const float4 b0 = qb[ti][ks][0], b1 = qb[ti][ks][1];
      union { bf16x8 v; unsigned u[4]; } a;
      a.u[0] = pack2(f[0] * __expf(b0.x), f[1] * __expf(b0.y)); a.u[1] = pack2(f[2] * __expf(b0.z), f[3] * __expf(b0.w));
      a.u[2] = pack2(f[4] * __expf(b1.x), f[5] * __expf(b1.y)); a.u[3] = pack2(f[6] * __expf(b1.z), f[7] * __expf(b1.w));
      qt[ti][ks] = a.v;
    }
  asm volatile("" ::: "memory");
  f32x4 o[2][8];
  {
    bf16x8 sf[8][2];
    const bfraw* sp = p.Sp + ((size_t)(bb * 128 + n) * 4 + h) * 8192 + (size_t)fr * 64 + fq * 8;
#pragma unroll
    for (int vt = 0; vt < 8; ++vt) { sf[vt][0] = *(const bf16x8*)(sp + vt * 1024); sf[vt][1] = *(const bf16x8*)(sp + vt * 1024 + 32); }
#pragma unroll
    for (int ti = 0; ti < 2; ++ti)
#pragma unroll
      for (int vt = 0; vt < 8; ++vt) {
        f32x4 a = (f32x4){0.f, 0.f, 0.f, 0.f};
        a = __builtin_amdgcn_mfma_f32_16x16x32_bf16(sf[vt][0], qt[ti][0], a, 0, 0, 0);
        a = __builtin_amdgcn_mfma_f32_16x16x32_bf16(sf[vt][1], qt[ti][1], a, 0, 0, 0);
        o[ti][vt] = a;
      }
  }
  asm volatile("" ::: "memory");
  bf16x8 vfr[2][8];
#pragma unroll
  for (int pr = 0; pr < 2; ++pr)
#pragma unroll
    for (int vt = 0; vt < 8; ++vt)
      vfr[pr][vt] = *(const bf16x8*)(p.zT + (size_t)(256 + h * 128 + vt * 16 + fr) * ZTP + m0 + pr * 32 + fq * 8);
#pragma unroll
  for (int ti = 0; ti < 2; ++ti) {
    const int t = (half * 2 + ti) * 16 + fr;
#pragma unroll
    for (int pr = 0; pr < 2; ++pr) {
      f32x4 at[2];
#pragma unroll
      for (int ab = 0; ab < 2; ++ab) {
        f32x4 a = (f32x4){0.f, 0.f, 0.f, 0.f};
        a = __builtin_amdgcn_mfma_f32_16x16x32_bf16(kt[pr][ab][0], qt[ti][0], a, 0, 0, 0);
        a = __builtin_amdgcn_mfma_f32_16x16x32_bf16(kt[pr][ab][1], qt[ti][1], a, 0, 0, 0);
#pragma unroll
        for (int j = 0; j < 4; ++j) {
          const int sidx = 32 * pr + fq * 8 + ab * 4 + j;
          a[j] = (sidx <= t) ? a[j] : 0.f;
        }
        at[ab] = a;
      }
      union { bf16x8 v; unsigned u[4]; } pb;
      pb.u[0] = pack2(at[0][0], at[0][1]); pb.u[1] = pack2(at[0][2], at[0][3]);
      pb.u[2] = pack2(at[1][0], at[1][1]); pb.u[3] = pack2(at[1][2], at[1][3]);
#pragma unroll
      for (int vt = 0; vt < 8; ++vt) o[ti][vt] = __builtin_amdgcn_mfma_f32_16x16x32_bf16(vfr[pr][vt], pb.v, o[ti][vt], 0, 0, 0);
    }
  }
  asm volatile("" ::: "memory");
#pragma unroll
  for (int ti = 0; ti < 2; ++ti) {
    const int m = m0 + (half * 2 + ti) * 16 + fr;
    uint2 gu[8];
#pragma unroll
    for (int vt = 0; vt < 8; ++vt) gu[vt] = *(const uint2*)(z + (size_t)m * ZC + 1024 + h * 128 + vt * 16 + fq * 4);
    float ss = 0.f;
#pragma unroll
    for (int vt = 0; vt < 8; ++vt) ss += o[ti][vt][0] * o[ti][vt][0] + o[ti][vt][1] * o[ti][vt][1] + o[ti][vt][2] * o[ti][vt][2] + o[ti][vt][3] * o[ti][vt][3];
    ss += shx(ss, 16); ss += shx(ss, 32);
    const float rs = rsqrtf(ss * (1.f / 128.f) + EPS);
#pragma unroll
    for (int vt = 0; vt < 8; ++vt) {
      const int v = vt * 16 + fq * 4;
      const float4 gn = *(const float4*)(p.gla_norm + l * 128 + v);
      const float g0 = __uint_as_float(gu[vt].x << 16), g1 = __uint_as_float(gu[vt].x & 0xffff0000u);
      const float g2 = __uint_as_float(gu[vt].y << 16), g3 = __uint_as_float(gu[vt].y & 0xffff0000u);
      uint2 ou;
      ou.x = pack2(o[ti][vt][0] * rs * gn.x * silu_f(g0), o[ti][vt][1] * rs * gn.y * silu_f(g1));
      ou.y = pack2(o[ti][vt][2] * rs * gn.z * silu_f(g2), o[ti][vt][3] * rs * gn.w * silu_f(g3));
      *(uint2*)(p.ocat + (size_t)m * 1024 + h * 128 + v) = ou;
    }
  }
}

DEVI void gla_sample_item(const Params& p, int l, int it, unsigned char* smem, HalfBar& hb) {
  const int tid = otid(), lane = tid & 63, w = tid >> 6;
  const int h = it & 3, bs = it >> 2;
  const bfraw* z = p.zh;
  float* eS = (float*)smem;
  float* qS = eS + 256;
  float* kS = qS + 256;
  float* vS = kS + 256;
  float* oS = vS + 512;
  const int mrow0 = MP + bs * 4;
  float S[32];
  {
    const float* sp = p.state_gla + ((((size_t)l * 128 + bs) * 4 + h) * 64 + (tid >> 7) * 32) * 128 + (tid & 127);
#pragma unroll
    for (int i = 0; i < 32; ++i) S[i] = __builtin_nontemporal_load(sp + (size_t)i * 128);
  }
  const float g0r = bf2f(z[(size_t)(mrow0 + w) * ZC + 1024 + h * 128 + lane]), g1r = bf2f(z[(size_t)(mrow0 + w) * ZC + 1024 + h * 128 + 64 + lane]);
  half_sync(hb);
  {
    const int t = w, k = lane;
    const float* gp = p.ga + (size_t)(mrow0 + t) * 16;
    float x = p.b_gk2[l * 256 + h * 64 + k];
#pragma unroll
    for (int r = 0; r < 16; ++r) x += gp[r] * p.w_gk2[((size_t)l * 16 + r) * 256 + h * 64 + k];
    eS[t * 64 + k] = __expf(logsig(x) * (1.f / 16.f));
    qS[t * 64 + k] = bf2f(z[(size_t)(mrow0 + t) * ZC + h * 64 + k]);
    kS[t * 64 + k] = bf2f(z[(size_t)(mrow0 + t) * ZC + 256 + h * 64 + k]);
    vS[t * 128 + k] = bf2f(z[(size_t)(mrow0 + t) * ZC + 512 + h * 128 + k]);
    vS[t * 128 + 64 + k] = bf2f(z[(size_t)(mrow0 + t) * ZC + 512 + h * 128 + 64 + k]);
  }
  half_sync(hb);
  {
    const int v = tid & 127, half = tid >> 7;
#pragma unroll
    for (int t = 0; t < 4; ++t) {
      const float vv = vS[t * 128 + v];
      float op = 0.f;
#pragma unroll
      for (int i = 0; i < 32; ++i) {
        const int k = half * 32 + i;
        S[i] = eS[t * 64 + k] * S[i] + kS[t * 64 + k] * vv;
        op += qS[t * 64 + k] * S[i];
      }
      oS[(t * 2 + half) * 128 + v] = op;
    }
    float* so = p.out + O_SSG + ((((size_t)l * 128 + bs) * 4 + h) * 64 + half * 32) * 128 + v;
#pragma unroll
    for (int i = 0; i < 32; ++i) __builtin_nontemporal_store(S[i], so + (size_t)i * 128);
  }
  half_sync(hb);
  {
    const int t = w;
    float o0 = oS[(t * 2) * 128 + lane] + oS[(t * 2 + 1) * 128 + lane];
    float o1 = oS[(t * 2) * 128 + 64 + lane] + oS[(t * 2 + 1) * 128 + 64 + lane];
    float ss = sum64(o0 * o0 + o1 * o1);
    const float rs = rsqrtf(ss * (1.f / 128.f) + EPS);
    const float g0 = g0r, g1 = g1r;
    bfraw* op = p.ocat + (size_t)(mrow0 + t) * 1024 + h * 128;
    op[lane] = f2bf(o0 * rs * p.gla_norm[l * 128 + lane] * silu_f(g0));
    op[64 + lane] = f2bf(o1 * rs * p.gla_norm[l * 128 + 64 + lane] * silu_f(g1));
  }
}

DEVI void final_item(const Params& p, int it) {
  const int tid = otid(), lane = tid & 63, w = tid >> 6;
  const int m = it * 4 + w;
  const float4* q = (const float4*)(p.ssq + (size_t)m * 16);
  float4 a = q[0], b = q[1], c = q[2], d = q[3];
  uint2 xr[4]; float4 g[4];
#pragma unroll
  for (int i = 0; i < 4; ++i) {
    const int col = lane * 4 + i * 256;
    xr[i] = *(const uint2*)(p.xb + (size_t)m * 1024 + col);
    g[i] = *(const float4*)(p.norm_final + col);
  }
  float s = ((a.x + a.y) + (a.z + a.w)) + ((b.x + b.y) + (b.z + b.w)) + ((c.x + c.y) + (c.z + c.w)) + ((d.x + d.y) + (d.z + d.w));
  const float rs = rsqrtf(s * (1.f / 1024.f) + EPS);
#pragma unroll
  for (int i = 0; i < 4; ++i) {
    const int col = lane * 4 + i * 256;
    float4 v = make_float4(__uint_as_float(xr[i].x << 16), __uint_as_float(xr[i].x & 0xffff0000u), __uint_as_float(xr[i].y << 16), __uint_as_float(xr[i].y & 0xffff0000u));
    v.x *= rs * g[i].x; v.y *= rs * g[i].y; v.z *= rs * g[i].z; v.w *= rs * g[i].w;
    ntst4(v, p.out + (size_t)m * 1024 + col);
  }
}

DEVI void run_phase(const Params& p, int ph, unsigned char* smem_all, int rep) {
  const int l = (ph - 1) / 9, s = (ph - 1) % 9;
  if (ph > 0 && ph < NPHASE - 1 && (s == 0 || s == 4 || s == 6 || s == 7)) {
    unsigned* qc = (l < 3) ? (p.qctr + (l * 2 + (s == 6)) * 16) : nullptr;
    if (s == 0) gemm_phase<EPI_IN>(p, l, p.xb, p.WinT + (size_t)l * NINP * 1024, 1024, 10, smem_all, qc, (l + 1) * 3008, (l + 1) * 3008 + 1760);
    else if (s == 6) gemm_phase<EPI_GU>(p, l, p.xb, p.WguT + (size_t)l * 5632 * 1024, 1024, 22, smem_all, qc, (l + 1) * 3008 + 1760, (l + 2) * 3008);
    else {
      const bool dn = (s == 7);
      gemm_res_phase(p, l, dn ? p.zh : p.ocat, dn ? (p.WdT + (size_t)l * 1024 * 2816) : (p.WoT + (size_t)l * 1024 * 1024),
                     dn ? DFF : 1024, dn ? 11 : 4, smem_all);
    }
    return;
  }
  const int vh = (otid512() >> 8) & 1;
  const int vb = blockIdx.x * 2 + vh, nvb = gridDim.x * 2;
  unsigned char* smem = smem_all + vh * 73728;
  if (ph == 0) { phase_prologue(p, smem, vb, nvb); return; }
  if (ph == NPHASE - 1) {
    for (int it = vb; it < M_TOK / 4; it += nvb) final_item(p, it);
    return;
  }
  switch (s) {
    case 1: {
      HalfBar hb; hb.cnt = (volatile LAS unsigned*)(smem_all + 2 * 73728 - 64 + vh * 32); hb.target = *hb.cnt;
      __syncthreads();
      if (vh == 0) {
        for (int it = blockIdx.x; it < 768; it += gridDim.x) {
          if (it < 512) gla_sample_item(p, l, it, smem, hb);
          else swa_sample_item(p, l, it - 512, smem, hb);
        }
      } else {
        for (int it = blockIdx.x; it < 1024; it += gridDim.x) gla_chunk_item(p, l, it, smem, hb);
      }
      prompt_cache_copy(p, l, vb, nvb);
      {
        const int wg = blockIdx.x * 8 + __builtin_amdgcn_readfirstlane(otid512() >> 6), nw = gridDim.x * 8;
        for (int wi = wg; wi < 2048; wi += nw) swa_prompt_wave(p, l, wi);
      }
    } break;
    case 2:
      for (int it = vb; it < 256; it += nvb) gla_scan_item(p, l, it);
      break;
    case 3: {
      const int wg = blockIdx.x * 8 + __builtin_amdgcn_readfirstlane(otid512() >> 6), nw = gridDim.x * 8;
      for (int wi = wg; wi < 2048; wi += nw) gla_out_wave(p, l, wi);
      {
        const uint4* wp = (const uint4*)(p.WoT + (size_t)l * 1024 * 1024) + (size_t)wg * 64 + lane_id();
        uint4 w0 = *wp;
        asm volatile("" :: "v"(w0.x), "v"(w0.y), "v"(w0.z), "v"(w0.w));
      }
    } break;
    case 5: {
      const int wg = blockIdx.x * 8 + __builtin_amdgcn_readfirstlane(otid512() >> 6), nw = gridDim.x * 8;
      for (int wi = wg; wi < 2048; wi += nw) fin_wave<4>(p, wi);
    } break;
    case 8: {
      const int wg = blockIdx.x * 8 + __builtin_amdgcn_readfirstlane(otid512() >> 6), nw = gridDim.x * 8;
      for (int wi = wg; wi < 2048; wi += nw) fin_wave<11>(p, wi);
    } break;
  }
}

__global__ void __launch_bounds__(512, 2) mega_kernel(Params p, int ph_lo, int ph_hi) {
  __shared__ __attribute__((aligned(16))) unsigned char smem[2 * 73728];
  uint4* xb_words = (uint4*)(smem + 2 * 73728 - 16);
  if (otid512() == 0) { *xb_words = make_uint4(0u, 0u, 0u, 0u); *(uint4*)(smem + 2 * 73728 - 64) = make_uint4(0u, 0u, 0u, 0u); *(uint4*)(smem + 2 * 73728 - 32) = make_uint4(0u, 0u, 0u, 0u); }
  __syncthreads();
  XcdBarrier xb = xcd_barrier_post(p.bar, (volatile LAS unsigned*)xb_words);
  if (ph_hi < 0) cg::this_grid().sync();
  for (int ph = ph_lo; ph < ph_hi; ++ph) {
    int reps = 1;
#ifdef DUP_MASK
    if (ph > 0 && ph < NPHASE - 1 && ((DUP_MASK >> ((ph - 1) % 9)) & 1)) reps = 2;
#endif
#ifdef DUP_PRO
    if (ph == 0) reps = 2;
#endif
    for (int r = 0; r < reps; ++r) {
      run_phase(p, ph, smem, r);
      if (ph + 1 < ph_hi || r + 1 < reps) xcd_barrier(xb);
    }
#ifdef DUP_SYNC
    if (ph > 0 && ph < NPHASE - 1) xcd_barrier(xb);
#endif
  }
}

extern "C" void kernel_launch(void* const* d_in, const int* in_sizes, int n_in, void* d_out, int out_size, void* d_ws,
                              size_t ws_size, hipStream_t stream) {
  static int grid_blocks = 0;
  if (!grid_blocks) {
    int dev = 0, cus = 0, per_cu = 0;
    hipGetDevice(&dev);
    hipDeviceGetAttribute(&cus, hipDeviceAttributeMultiprocessorCount, dev);
    hipOccupancyMaxActiveBlocksPerMultiprocessor(&per_cu, mega_kernel, 512, 0);
    if (per_cu < 1) per_cu = 1;
    if (per_cu > 1) per_cu = 1;
    grid_blocks = cus * per_cu;
  }
  Params p{};
  p.x_prompt = (const float*)d_in[0]; p.x_sample = (const float*)d_in[1]; p.state_gla = (const float*)d_in[2];
  p.cache_k = (const float*)d_in[3]; p.cache_v = (const float*)d_in[4]; p.norm_attn = (const float*)d_in[5];
  p.w_in = (const float*)d_in[6]; p.w_gk2 = (const float*)d_in[7]; p.b_gk2 = (const float*)d_in[8];
  p.gla_norm = (const float*)d_in[9]; p.sinks = (const float*)d_in[10]; p.w_o = (const float*)d_in[11];
  p.norm_ffn = (const float*)d_in[12]; p.w_gate = (const float*)d_in[13]; p.w_up = (const float*)d_in[14];
  p.w_down = (const float*)d_in[15]; p.norm_final = (const float*)d_in[16];
  p.out = (float*)d_out;
  unsigned char* ws = (unsigned char*)d_ws;
  size_t off = 0;
  auto take = [&](size_t bytes) { unsigned char* r = ws + off; off += (bytes + 255) & ~(size_t)255; return r; };
  p.WinT = (bfraw*)take((size_t)4 * NINP * 1024 * 2);
  p.WoT = (bfraw*)take((size_t)4 * 1024 * 1024 * 2);
  p.WguT = (bfraw*)take((size_t)4 * 5632 * 1024 * 2);
  p.WdT = (bfraw*)take((size_t)4 * 1024 * 2816 * 2);
  p.xb = (bfraw*)take((size_t)M_TOK * 1024 * 2);
  p.zh = (bfraw*)take((size_t)M_TOK * DFF * 2);
  p.ocat = (bfraw*)take((size_t)M_TOK * 1024 * 2);
  p.zT = (bfraw*)take((size_t)896 * ZTP * 2);
  p.ssq = (float*)take((size_t)M_TOK * 16 * 4);
  p.ga = (float*)take((size_t)M_TOK * 16 * 4);
  p.U = (float*)take((size_t)2 * 128 * 4 * 8192 * 4);
  p.dn = (float*)take((size_t)2 * 128 * 4 * 64 * 4);
  p.Sp = (bfraw*)take((size_t)2 * 128 * 4 * 8192 * 2);
  p.bbuf = (float*)take((size_t)MP * 256 * 4);
  p.rope = (float2*)take((size_t)8196 * 32 * 8);
  p.bar = (unsigned*)take((size_t)(XCD_BAR_WORDS + 256) * 4);
  p.qctr = p.bar + XCD_BAR_WORDS;
  if (off > ws_size) { fprintf(stderr, "workspace too small: need %zu have %zu\n", off, ws_size); return; }
  (void)hipMemsetAsync(p.bar, 0, (size_t)(XCD_BAR_WORDS + 256) * 4, stream);
#if MULTI_LAUNCH
  for (int ph = 0; ph < NPHASE; ++ph) {
    hipLaunchKernelGGL(mega_kernel, dim3(grid_blocks), dim3(512), 0, stream, p, ph, ph + 1);
  }
#else
  int lo = 0, hi = NPHASE;
  void* args[] = {&p, &lo, &hi};
  hipError_t e = hipLaunchCooperativeKernel((void*)mega_kernel, dim3(grid_blocks), dim3(512), args, 0, stream);
  if (e != hipSuccess) fprintf(stderr, "cooperative launch failed: %s (grid %d)\n", hipGetErrorString(e), grid_blocks);
#endif
}
```
